# Optimizing an MI355X kernel written in HIP

```python
import math
import jax, jax.numpy as jnp
from jax import lax
import numpy as np

D_MODEL = 1024
BATCH = 8
SEQ = 4096
DEPTH = 4

ATT_HEADS = 8
HEAD_DIM = 64
ATT_WIDTH = ATT_HEADS * HEAD_DIM
CONV_GROUPS = 8
CONV_WIDTH = D_MODEL - ATT_WIDTH
CONV_K = 3
FFN_CONV_K = 3
D_FF = 2816
Q_BLOCK = 128
RMS_EPS = 1e-6
IN_COLS = 3 * ATT_WIDTH + 3 * CONV_WIDTH + 2 * D_MODEL
IN_SPLITS = (ATT_WIDTH, 2 * ATT_WIDTH, 3 * ATT_WIDTH,
             3 * ATT_WIDTH + CONV_WIDTH, 3 * ATT_WIDTH + 2 * CONV_WIDTH,
             3 * ATT_WIDTH + 3 * CONV_WIDTH, 3 * ATT_WIDTH + 3 * CONV_WIDTH + D_MODEL)

kernel_name = "hybrid_stickbreak_shortconv_convffn"


def rms_norm(x, g):
    xf = x.astype(jnp.float32)
    var = jnp.mean(xf * xf, axis=-1, keepdims=True)
    return (xf * lax.rsqrt(var + RMS_EPS) * g.astype(jnp.float32)).astype(x.dtype)


def causal_dwconv(u, w):
    kw = w.shape[0]
    s = u.shape[1]
    up = jnp.pad(u, ((0, 0), (kw - 1, 0), (0, 0)))
    y = up[:, 0:s, :] * w[0]
    for i in range(1, kw):
        y = y + up[:, i:i + s, :] * w[i]
    return y


def stick_breaking_attention(q, k, v):
    _, _, s, dh = q.shape
    scale = 1.0 / math.sqrt(dh)
    outs = []
    for blk in range(s // Q_BLOCK):
        t0 = blk * Q_BLOCK
        t1 = t0 + Q_BLOCK
        qb = q[:, :, t0:t1]
        kb = k[:, :, :t1]
        vb = v[:, :, :t1]
        z = jnp.einsum("bhqd,bhkd->bhqk", qb, kb).astype(jnp.float32) * scale
        t_idx = t0 + jnp.arange(Q_BLOCK)[:, None]
        s_idx = jnp.arange(t1)[None, :]
        strict = s_idx < t_idx
        log_keep = jnp.where(strict, jax.nn.log_sigmoid(-z), 0.0)
        later = lax.cumsum(log_keep, axis=3, reverse=True) - log_keep
        w = jnp.where(strict, jnp.exp(jax.nn.log_sigmoid(z) + later), 0.0)
        outs.append(jnp.einsum("bhqk,bhkd->bhqd", w, vb.astype(jnp.float32)))
    return jnp.concatenate(outs, axis=2).astype(q.dtype)


def setup_inputs(seed: int = 0) -> dict:
    key = jax.random.key(seed)
    ks = jax.random.split(key, 14)
    f32 = jnp.float32

    def nrm(k, shape, fan_in):
        return jax.random.normal(k, shape, f32) * (fan_in ** -0.5)

    def gain(k):
        return 1.0 + 0.05 * jax.random.normal(k, (DEPTH, D_MODEL), f32)

    return {
        "x": jax.random.normal(ks[0], (BATCH, SEQ, D_MODEL), f32),
        "norm_mix_pre": gain(ks[1]),
        "w_in": nrm(ks[2], (DEPTH, D_MODEL, IN_COLS), D_MODEL),
        "conv_mix_w": nrm(ks[3], (DEPTH, CONV_K, CONV_WIDTH), CONV_K),
        "w_att_branch": nrm(ks[4], (DEPTH, ATT_WIDTH, D_MODEL), ATT_WIDTH),
        "w_conv_branch": nrm(ks[5], (DEPTH, CONV_WIDTH, D_MODEL), CONV_WIDTH),
        "w_out": nrm(ks[6], (DEPTH, D_MODEL, D_MODEL), D_MODEL),
        "norm_mix_post": gain(ks[7]),
        "norm_ffn_pre": gain(ks[8]),
        "w_up": nrm(ks[9], (DEPTH, D_MODEL, 2 * D_FF), D_MODEL),
        "conv_ffn_w": nrm(ks[10], (DEPTH, FFN_CONV_K, 2 * D_FF), FFN_CONV_K),
        "w_down": nrm(ks[11], (DEPTH, D_FF, D_MODEL), D_FF),
        "norm_ffn_post": gain(ks[12]),
    }


def reference(x, norm_mix_pre, w_in, conv_mix_w, w_att_branch, w_conv_branch, w_out,
              norm_mix_post, norm_ffn_pre, w_up, conv_ffn_w, w_down, norm_ffn_post):
    b, s, _ = x.shape
    for l in range(DEPTH):
        h = rms_norm(x, norm_mix_pre[l])
        proj = h @ w_in[l]
        q, k, v, cb, cc, cx, g_att, g_conv = jnp.split(proj, IN_SPLITS, axis=-1)

        def heads(t):
            return t.reshape(b, s, ATT_HEADS, HEAD_DIM).transpose(0, 2, 1, 3)

        o = stick_breaking_attention(heads(q), heads(k), heads(v))
        y_att = o.transpose(0, 2, 1, 3).reshape(b, s, ATT_WIDTH) @ w_att_branch[l]

        y_conv = (cb * causal_dwconv(cc * cx, conv_mix_w[l])) @ w_conv_branch[l]

        merged = jax.nn.sigmoid(g_att) * y_att + jax.nn.sigmoid(g_conv) * y_conv
        x = x + rms_norm(merged @ w_out[l], norm_mix_post[l])

        h = rms_norm(x, norm_ffn_pre[l])
        u = causal_dwconv(h @ w_up[l], conv_ffn_w[l])
        a, g = jnp.split(u, 2, axis=-1)
        f = (jax.nn.gelu(g, approximate=True) * a) @ w_down[l]
        x = x + rms_norm(f, norm_ffn_post[l])
    return x
```

```cpp
#include <hip/hip_runtime.h>
#include <hip/hip_cooperative_groups.h>
#include <cstdio>
#include <cstdint>
namespace cg = cooperative_groups;

#define LAS __attribute__((address_space(3)))
typedef unsigned short bf16_t;
typedef _Float16 f16_t;
typedef short bf16x8 __attribute__((ext_vector_type(8)));
typedef float f32x4 __attribute__((ext_vector_type(4)));
typedef float f32x16 __attribute__((ext_vector_type(16)));
typedef unsigned u32x4 __attribute__((ext_vector_type(4)));
typedef unsigned u32x2 __attribute__((ext_vector_type(2)));
typedef _Float16 h16x8 __attribute__((ext_vector_type(8)));
typedef _Float16 h16x4 __attribute__((ext_vector_type(4)));

constexpr int D_MODEL = 1024, BATCH = 8, SEQ = 4096, DEPTH = 4, NHEAD = 8, HDIM = 64, ATTW = 512, CONVW = 512, D_FF = 2816, IN_COLS = 5120;
constexpr int MTOT = BATCH * SEQ;
constexpr int NHALF = 2, MH = MTOT / NHALF;
constexpr float RMS_EPS = 1e-6f;
constexpr float QSCALE = 0.18033688011112042f;

constexpr size_t MiB = 1u << 20;
constexpr size_t WS_R = 1 * MiB;
constexpr size_t WS_W = 2 * MiB;
constexpr size_t W_IN = 0, W_BR = W_IN + (size_t)IN_COLS * 1024 * 2, W_OUT = W_BR + 2 * MiB, W_UP = W_OUT + 2 * MiB, W_DN = W_UP + (size_t)2 * D_FF * 1024 * 2, W_LAYER = W_DN + (size_t)1024 * D_FF * 2;
static_assert(W_LAYER == 31981568, "weights per layer");
constexpr size_t WS_XB = 124 * MiB;
constexpr size_t WS_SSQ = 156 * MiB;
constexpr size_t WS_Q = 158 * MiB, WS_K = 174 * MiB, WS_VT = 190 * MiB, WS_CCC = 206 * MiB, WS_G = 254 * MiB, WS_OU = 318 * MiB, WS_MG = 350 * MiB, WS_T = 382 * MiB;
constexpr size_t WS_U = 158 * MiB, WS_ACT = 334 * MiB, WS_F = 422 * MiB, WS_END = 454 * MiB;
static_assert(WS_W + 4 * W_LAYER <= WS_XB, "weights fit");
static_assert(WS_U + (size_t)MH * 2 * D_FF * 2 <= WS_ACT && WS_ACT + (size_t)MH * D_FF * 2 <= WS_F, "ffn map");

constexpr int LDS_BYTES = 147456;

namespace pg8 {
constexpr int BM = 256, BK = 64, HALF = 128, HTB = HALF * BK * 2, STAGE_BYTES = 8 * HTB, NXCD = 8, WGM = 8;
__host__ __device__ __forceinline__ int lds_byte(int r, int c) { const int st = (r >> 4) * 2 + (c >> 5), rr = r & 15, cc = c & 31, ob = rr * 64 + cc * 2; return st * 1024 + (ob ^ (((ob >> 9) & 1) << 5)); }
__host__ __device__ __forceinline__ void stage_rc(int b, int& R, int& C) { const int st = b / 1024, sb = b % 1024, swz = sb ^ (((sb >> 9) & 1) << 5); R = (st >> 1) * 16 + swz / 64; C = (st & 1) * 32 + (swz % 64) / 2; }
__host__ __device__ __forceinline__ int perm32(int rho) { const int n = rho >> 4, i = rho & 15; return 8 * (i >> 2) + 4 * n + (i & 3); }

struct Unit { int pm, pn; };
struct Gemm { const bf16_t* A; const bf16_t* Bt; int M, N, K; };
struct StaticOrder {
    int nM, nN, nwg, G, c;
    __device__ void init(int M, int N, int G_, int c_) { nM = M / BM; nN = N / BM; nwg = nM * nN; G = G_; c = c_; }
    __device__ bool next(int i, Unit& u) const {
        const long L = (long)i * G + c; if (L >= nwg) return false;
        int wgid = (int)L; { const int q = nwg / NXCD, r = nwg % NXCD, xcd = wgid % NXCD, off = wgid / NXCD; wgid = (xcd < r ? xcd * (q + 1) : r * (q + 1) + (xcd - r) * q) + off; }
        const int nig = WGM * nN, gid = wgid / nig, fm = gid * WGM, gsz = (nM - fm) < WGM ? (nM - fm) : WGM;
        u.pm = fm + ((wgid % nig) % gsz); u.pn = (wgid % nig) / gsz; return true;
    }
};

typedef __bf16 bf16x2_v __attribute__((ext_vector_type(2)));
typedef float f32x2_v __attribute__((ext_vector_type(2)));
__device__ __forceinline__ unsigned cvt_pk_bf16(float lo, float hi) { const f32x2_v f = {lo, hi}; const bf16x2_v r = __builtin_convertvector(f, bf16x2_v); return __builtin_bit_cast(unsigned, r); }
__device__ __forceinline__ u32x4 pack8_bf16(f32x4 v0, f32x4 v1) { u32x4 w; w.x = cvt_pk_bf16(v0[0], v0[1]); w.y = cvt_pk_bf16(v0[2], v0[3]); w.z = cvt_pk_bf16(v1[0], v1[1]); w.w = cvt_pk_bf16(v1[2], v1[3]); return w; }
__device__ __forceinline__ float bf_lo(unsigned w) { return __uint_as_float(w << 16); }
__device__ __forceinline__ float bf_hi(unsigned w) { return __uint_as_float(w & 0xffff0000u); }
__device__ __forceinline__ float sigmoidf_(float x) { return __builtin_amdgcn_rcpf(1.0f + __builtin_amdgcn_exp2f(-1.4426950408889634f * x)); }


struct EpiIn {
    static constexpr bool PERM = true, HAS_MID = false;
    const float* rs; f16_t* Q; f16_t* Kb; f16_t* VT; bf16_t* CCC; bf16_t* G;
    __device__ __forceinline__ void mid(f32x4 (&)[2][2][4][2], const Unit&, int, int, int, int) const {}
    __device__ __forceinline__ void operator()(const f32x4 (&acc)[2][2][4][2], const Unit& u, int wr, int wc, int fr, int fq) const {
        asm volatile("" : "+v"(fr), "+v"(fq));
        const int pn = u.pn, row0 = u.pm * BM + wr * 64 + fr;
#pragma unroll
        for (int ai = 0; ai < 2; ++ai)
#pragma unroll
            for (int m = 0; m < 4; ++m) {
                const int r = row0 + ai * HALF + m * 16; const float sc = rs[r]; const int b = r >> 12, s = r & 4095;
#pragma unroll
                for (int bj = 0; bj < 2; ++bj) {
                    const int c = pn * 256 + bj * HALF + wc * 32 + 8 * fq;
                    f32x4 v0 = acc[ai][bj][m][0] * sc, v1 = acc[ai][bj][m][1] * sc;
                    if (pn < 4) {
                        const int cc = c & 511, head = cc >> 6, d = cc & 63;
                        if (pn < 2) { v0 = v0 * QSCALE; v1 = v1 * QSCALE; }
                        h16x8 o; o[0] = (f16_t)v0[0]; o[1] = (f16_t)v0[1]; o[2] = (f16_t)v0[2]; o[3] = (f16_t)v0[3]; o[4] = (f16_t)v1[0]; o[5] = (f16_t)v1[1]; o[6] = (f16_t)v1[2]; o[7] = (f16_t)v1[3];
                        f16_t* base = (pn < 2 ? Q : Kb) + ((size_t)((b * 8 + head) * 4096 + s) * 64 + d);
                        *(h16x8*)base = o;
                    } else if (pn < 6) {
                        const int cc = c - 1024, head = cc >> 6, d = cc & 63;
                        f16_t* base = VT + ((size_t)(((b * 8 + head) * 128 + (s >> 5)) * 64 + d) * 32 + (s & 31));
                        base[0 * 32] = (f16_t)v0[0]; base[1 * 32] = (f16_t)v0[1]; base[2 * 32] = (f16_t)v0[2]; base[3 * 32] = (f16_t)v0[3];
                        base[4 * 32] = (f16_t)v1[0]; base[5 * 32] = (f16_t)v1[1]; base[6 * 32] = (f16_t)v1[2]; base[7 * 32] = (f16_t)v1[3];
                    } else if (pn < 12) {
                        *(u32x4*)(CCC + (size_t)r * 1536 + (c - 1536)) = pack8_bf16(v0, v1);
                    } else {
#pragma unroll
                        for (int j = 0; j < 4; ++j) { v0[j] = sigmoidf_(v0[j]); v1[j] = sigmoidf_(v1[j]); }
                        *(u32x4*)(G + (size_t)r * 2048 + (c - 3072)) = pack8_bf16(v0, v1);
                    }
                }
            }
    }
};
struct EpiMerge {
    static constexpr bool PERM = true, HAS_MID = true;
    const bf16_t* G; bf16_t* O;
    __device__ __forceinline__ void mid(f32x4 (&acc)[2][2][4][2], const Unit& u, int wr, int wc, int fr, int fq) const {
        asm volatile("" : "+v"(fr), "+v"(fq));
        const int row0 = u.pm * BM + wr * 64 + fr;
#pragma unroll
        for (int ai = 0; ai < 2; ++ai)
#pragma unroll
            for (int m = 0; m < 4; ++m) {
                const int r = row0 + ai * HALF + m * 16;
#pragma unroll
                for (int bj = 0; bj < 2; ++bj) {
                    const int c = u.pn * 256 + bj * HALF + wc * 32 + 8 * fq;
                    const u32x4 ga = *(const u32x4*)(G + (size_t)r * 2048 + c), gc = *(const u32x4*)(G + (size_t)r * 2048 + 1024 + c);
#pragma unroll
                    for (int q = 0; q < 4; ++q) {
                        const float a0 = bf_lo(ga[q]), a1 = bf_hi(ga[q]), c0 = fmaxf(bf_lo(gc[q]), 1e-20f), c1 = fmaxf(bf_hi(gc[q]), 1e-20f);
                        acc[ai][bj][m][q >> 1][(q & 1) * 2 + 0] *= a0 * __builtin_amdgcn_rcpf(c0);
                        acc[ai][bj][m][q >> 1][(q & 1) * 2 + 1] *= a1 * __builtin_amdgcn_rcpf(c1);
                    }
                }
            }
    }
    __device__ __forceinline__ void operator()(const f32x4 (&acc)[2][2][4][2], const Unit& u, int wr, int wc, int fr, int fq) const {
        asm volatile("" : "+v"(fr), "+v"(fq));
        const int row0 = u.pm * BM + wr * 64 + fr;
#pragma unroll
        for (int ai = 0; ai < 2; ++ai)
#pragma unroll
            for (int m = 0; m < 4; ++m) {
                const int r = row0 + ai * HALF + m * 16;
#pragma unroll
                for (int bj = 0; bj < 2; ++bj) {
                    const int c = u.pn * 256 + bj * HALF + wc * 32 + 8 * fq;
                    const u32x4 gc = *(const u32x4*)(G + (size_t)r * 2048 + 1024 + c);
                    f32x4 v0 = acc[ai][bj][m][0], v1 = acc[ai][bj][m][1];
                    v0[0] *= fmaxf(bf_lo(gc[0]), 1e-20f); v0[1] *= fmaxf(bf_hi(gc[0]), 1e-20f); v0[2] *= fmaxf(bf_lo(gc[1]), 1e-20f); v0[3] *= fmaxf(bf_hi(gc[1]), 1e-20f);
                    v1[0] *= fmaxf(bf_lo(gc[2]), 1e-20f); v1[1] *= fmaxf(bf_hi(gc[2]), 1e-20f); v1[2] *= fmaxf(bf_lo(gc[3]), 1e-20f); v1[3] *= fmaxf(bf_hi(gc[3]), 1e-20f);
                    *(u32x4*)(O + (size_t)r * 1024 + c) = pack8_bf16(v0, v1);
                }
            }
    }
};
struct EpiNormOut {
    static constexpr bool PERM = true, HAS_MID = false;
    bf16_t* O; float* ssq;
    __device__ __forceinline__ void mid(f32x4 (&)[2][2][4][2], const Unit&, int, int, int, int) const {}
    __device__ __forceinline__ void operator()(const f32x4 (&acc)[2][2][4][2], const Unit& u, int wr, int wc, int fr, int fq) const {
        asm volatile("" : "+v"(fr), "+v"(fq));
        const int row0 = u.pm * BM + wr * 64 + fr;
#pragma unroll
        for (int ai = 0; ai < 2; ++ai)
#pragma unroll
            for (int m = 0; m < 4; ++m) {
                const int r = row0 + ai * HALF + m * 16; float q = 0.f;
#pragma unroll
                for (int bj = 0; bj < 2; ++bj) {
                    const int c = u.pn * 256 + bj * HALF + wc * 32 + 8 * fq;
                    const f32x4 v0 = acc[ai][bj][m][0], v1 = acc[ai][bj][m][1];
                    q += (v0[0] * v0[0] + v0[1] * v0[1]) + (v0[2] * v0[2] + v0[3] * v0[3]) + (v1[0] * v1[0] + v1[1] * v1[1]) + (v1[2] * v1[2] + v1[3] * v1[3]);
                    *(u32x4*)(O + (size_t)r * 1024 + c) = pack8_bf16(v0, v1);
                }
                q += __shfl_xor(q, 16); q += __shfl_xor(q, 32);
                if (fq == 0) ssq[(size_t)r * 16 + u.pn * 4 + wc] = q;
            }
    }
};
struct EpiScale {
    static constexpr bool PERM = true, HAS_MID = false;
    const float* rs; bf16_t* O; int ldc;
    __device__ __forceinline__ void mid(f32x4 (&)[2][2][4][2], const Unit&, int, int, int, int) const {}
    __device__ __forceinline__ void operator()(const f32x4 (&acc)[2][2][4][2], const Unit& u, int wr, int wc, int fr, int fq) const {
        asm volatile("" : "+v"(fr), "+v"(fq));
        const int row0 = u.pm * BM + wr * 64 + fr;
#pragma unroll
        for (int ai = 0; ai < 2; ++ai)
#pragma unroll
            for (int m = 0; m < 4; ++m) {
                const int r = row0 + ai * HALF + m * 16; const float sc = rs[r];
#pragma unroll
                for (int bj = 0; bj < 2; ++bj) {
                    const int c = u.pn * 256 + bj * HALF + wc * 32 + 8 * fq;
                    *(u32x4*)(O + (size_t)r * ldc + c) = pack8_bf16(acc[ai][bj][m][0] * sc, acc[ai][bj][m][1] * sc);
                }
            }
    }
};

template <class Epi>
__device__ __forceinline__ void gemm_phase(LAS unsigned char* lds, const Gemm g, const StaticOrder& S, const Epi& E, const int wid, const int lane) {
    const int tid = wid * 64 + lane, wr = wid >> 2, wc = wid & 3, fr = lane & 15, fq = lane >> 4;
    const int K = g.K, nt = K / BK;
    unsigned voffA[2], voffB[2];
#pragma unroll
    for (int i = 0; i < 2; ++i) { int R, C; stage_rc(tid * 16 + i * 8192, R, C); const int Rb = Epi::PERM ? ((R & ~31) + perm32(R & 31)) : R;
        voffA[i] = (unsigned)(R * K + C) * 2u; voffB[i] = (unsigned)(Rb * K + C) * 2u; }
    const size_t kstep = (size_t)(BK * 2);
    const size_t hstep = (size_t)HALF * K * 2;
    const size_t tstep = 2 * hstep;
    const unsigned ldsw = (unsigned)wid * 1024u;
    const int aoff = lds_byte(wr * 64 + fr, fq * 8), boff = lds_byte(wc * 32 + fr, fq * 8);
#define PG8_SA(b, h) (((b) * 2 + (h)) * HTB)
#define PG8_SB(b, h) ((4 + (b) * 2 + (h)) * HTB)
#define PG8_STAGE(bufoff, gbase, voff) do { _Pragma("unroll") for (int _i = 0; _i < 2; ++_i) \
        __builtin_amdgcn_global_load_lds((const unsigned*)((const char*)(gbase) + (voff)[_i]), (LAS unsigned*)(lds + (bufoff) + ldsw + _i * 8192), 16, 0, 0); } while (0)
#define PG8_LDA(dst, b, h) do { _Pragma("unroll") for (int m = 0; m < 4; ++m) _Pragma("unroll") for (int k = 0; k < 2; ++k) dst[m][k] = *(const LAS bf16x8*)(lds + PG8_SA(b, h) + aoff + m * 2048 + k * 1024); } while (0)
#define PG8_LDB(dst, b, h) do { _Pragma("unroll") for (int n = 0; n < 2; ++n) _Pragma("unroll") for (int k = 0; k < 2; ++k) dst[n][k] = *(const LAS bf16x8*)(lds + PG8_SB(b, h) + boff + n * 2048 + k * 1024); } while (0)
#define PG8_MMA(ai, bj, At, Bt) do { __builtin_amdgcn_s_setprio(1); _Pragma("unroll") for (int m = 0; m < 4; ++m) _Pragma("unroll") for (int n = 0; n < 2; ++n) _Pragma("unroll") for (int k = 0; k < 2; ++k) \
        acc[ai][bj][m][n] = __builtin_amdgcn_mfma_f32_16x16x32_bf16(Bt[n][k], At[m][k], acc[ai][bj][m][n], 0, 0, 0); __builtin_amdgcn_s_setprio(0); } while (0)
#define PG8_WAIT_V(n) asm volatile("s_waitcnt vmcnt(" #n ")" ::: "memory")
#define PG8_WAIT_L(n) asm volatile("s_waitcnt lgkmcnt(" #n ")" ::: "memory")
#define PG8_BAR __builtin_amdgcn_s_barrier()
#define PG8_SCHED __builtin_amdgcn_sched_barrier(0)
    Unit cur, nxt; int ui = 0;
    if (!S.next(0, cur)) return;
    f32x4 acc[2][2][4][2];
#pragma unroll
    for (int a = 0; a < 2; ++a)
#pragma unroll
        for (int b = 0; b < 2; ++b)
#pragma unroll
            for (int m = 0; m < 4; ++m)
#pragma unroll
                for (int n = 0; n < 2; ++n) acc[a][b][m][n] = (f32x4){0.f, 0.f, 0.f, 0.f};
    bf16x8 At[4][2], B0[2][2], B1[2][2];
    const char* cA = (const char*)g.A + (size_t)cur.pm * tstep; const char* cB = (const char*)g.Bt + (size_t)cur.pn * tstep;
    PG8_STAGE(PG8_SB(0, 0), cB, voffB); PG8_STAGE(PG8_SB(0, 1), cB + hstep, voffB); PG8_STAGE(PG8_SA(0, 0), cA, voffA); PG8_STAGE(PG8_SA(0, 1), cA + hstep, voffA);
    if (wr == 1) PG8_BAR;
    PG8_WAIT_V(2); PG8_BAR;
    PG8_STAGE(PG8_SB(1, 0), cB + kstep, voffB); PG8_STAGE(PG8_SA(1, 0), cA + kstep, voffA); PG8_STAGE(PG8_SB(1, 1), cB + hstep + kstep, voffB);
    PG8_WAIT_V(6); PG8_BAR;
    for (;;) {
        const bool has_next = S.next(ui + 1, nxt);
        const char* nA = has_next ? (const char*)g.A + (size_t)nxt.pm * tstep : cA; const char* nB = has_next ? (const char*)g.Bt + (size_t)nxt.pn * tstep : cB;
        for (int t = 0; t < nt; t += 2) {
            const bool last = (t == nt - 2);
            const char* a1 = cA + (size_t)(t + 1) * kstep;
            const char* a2 = last ? nA : cA + (size_t)(t + 2) * kstep; const char* b2 = last ? nB : cB + (size_t)(t + 2) * kstep;
            const char* a3 = a2 + kstep; const char* b3 = b2 + kstep;
            if constexpr (Epi::HAS_MID) { if (t == (nt >> 1)) E.mid(acc, cur, wr, wc, fr, fq); }
            PG8_LDB(B0, 0, 0); PG8_LDB(B1, 0, 1); PG8_SCHED; PG8_LDA(At, 0, 0); PG8_STAGE(PG8_SA(1, 1), a1 + hstep, voffA);
            PG8_WAIT_V(8); PG8_WAIT_L(0); PG8_BAR; PG8_MMA(0, 0, At, B0); PG8_MMA(0, 1, At, B1); PG8_BAR; PG8_SCHED;
            PG8_LDA(At, 0, 1); PG8_STAGE(PG8_SB(0, 0), b2, voffB); PG8_STAGE(PG8_SB(0, 1), b2 + hstep, voffB); PG8_STAGE(PG8_SA(0, 0), a2, voffA);
            PG8_WAIT_V(8); PG8_WAIT_L(0); PG8_BAR; PG8_MMA(1, 0, At, B0); PG8_MMA(1, 1, At, B1); PG8_BAR; PG8_SCHED;
            PG8_LDB(B0, 1, 0); PG8_LDB(B1, 1, 1); PG8_SCHED; PG8_LDA(At, 1, 0); PG8_STAGE(PG8_SA(0, 1), a2 + hstep, voffA);
            PG8_WAIT_V(8); PG8_WAIT_L(0); PG8_BAR; PG8_MMA(0, 0, At, B0); PG8_MMA(0, 1, At, B1); PG8_BAR; PG8_SCHED;
            PG8_LDA(At, 1, 1); PG8_STAGE(PG8_SB(1, 0), b3, voffB); PG8_STAGE(PG8_SB(1, 1), b3 + hstep, voffB); PG8_STAGE(PG8_SA(1, 0), a3, voffA);
            PG8_WAIT_V(8); PG8_WAIT_L(0); PG8_BAR; PG8_MMA(1, 0, At, B0); PG8_MMA(1, 1, At, B1); PG8_BAR; PG8_SCHED;
        }
        if (wr == 0) PG8_BAR;
        E(acc, cur, wr, wc, fr, fq);
        if (!has_next) break;
#pragma unroll
        for (int a = 0; a < 2; ++a)
#pragma unroll
            for (int b = 0; b < 2; ++b)
#pragma unroll
                for (int m = 0; m < 4; ++m)
#pragma unroll
                    for (int n = 0; n < 2; ++n) acc[a][b][m][n] = (f32x4){0.f, 0.f, 0.f, 0.f};
        cur = nxt; cA = nA; cB = nB; ++ui;
        if (wr == 1) PG8_BAR;
    }
    PG8_WAIT_V(0);
    PG8_BAR;
#undef PG8_SA
#undef PG8_SB
#undef PG8_STAGE
#undef PG8_LDA
#undef PG8_LDB
#undef PG8_MMA
#undef PG8_WAIT_V
#undef PG8_WAIT_L
#undef PG8_BAR
#undef PG8_SCHED
}
}
using pg8::cvt_pk_bf16; using pg8::bf_lo; using pg8::bf_hi;

#define LDS_WAIT() asm volatile("s_waitcnt lgkmcnt(0)" ::: "memory")
__device__ __forceinline__ float wave_sum(float v) {
#pragma unroll
    for (int o = 1; o < 64; o <<= 1) v += __shfl_xor(v, o);
    return v;
}

__device__ __forceinline__ void tr_item(const float* W, int N, const float* g, bf16_t* WT, int ldT, int k_off, LAS float* scr, int item, int lane) {
    const int nblk = N / 32, kb = item / nblk, nb = item % nblk, k0 = 64 * kb, n0 = 32 * nb;
#pragma unroll 8
    for (int i = 0; i < 32; ++i) { const int kk = 2 * i + (lane >> 5); float v = W[(size_t)(k0 + kk) * N + n0 + (lane & 31)]; if (g) v *= g[k0 + kk]; scr[kk * 33 + (lane & 31)] = v; }
    LDS_WAIT(); asm volatile("" ::: "memory");
    const int c = lane & 7;
#pragma unroll
    for (int j = 0; j < 4; ++j) { const int n = (lane >> 3) + 8 * j; const LAS float* s = scr + (8 * c) * 33 + n;
        u32x4 o; o.x = cvt_pk_bf16(s[0 * 33], s[1 * 33]); o.y = cvt_pk_bf16(s[2 * 33], s[3 * 33]); o.z = cvt_pk_bf16(s[4 * 33], s[5 * 33]); o.w = cvt_pk_bf16(s[6 * 33], s[7 * 33]);
        *(u32x4*)(WT + (size_t)(n0 + n) * ldT + k_off + k0 + 8 * c) = o; }
    LDS_WAIT(); asm volatile("" ::: "memory");
}
__device__ __forceinline__ void pro_row(const float* xrow, bf16_t* xb, float* rout, int lane) {
    const f32x4* xr = (const f32x4*)xrow + lane; f32x4 v[4]; float s = 0.f;
#pragma unroll
    for (int j = 0; j < 4; ++j) { v[j] = xr[64 * j]; s += (v[j].x * v[j].x + v[j].y * v[j].y) + (v[j].z * v[j].z + v[j].w * v[j].w); }
    s = wave_sum(s);
    u32x2* o8 = (u32x2*)xb + lane;
#pragma unroll
    for (int j = 0; j < 4; ++j) { u32x2 w; w.x = cvt_pk_bf16(v[j].x, v[j].y); w.y = cvt_pk_bf16(v[j].z, v[j].w); o8[64 * j] = w; }
    if (lane == 0) *rout = 1.0f / sqrtf(s * (1.0f / 1024.0f) + RMS_EPS);
}
__device__ __forceinline__ void res_row(const float* xsrc, float* xdst, const bf16_t* t, const float* ssq16, const float* gpost, bf16_t* xb, float* rout, int lane) {
    const f32x4* sp = (const f32x4*)ssq16; const f32x4 s0 = sp[0], s1 = sp[1], s2 = sp[2], s3 = sp[3];
    const float tot = (((s0.x + s0.y) + (s0.z + s0.w)) + ((s1.x + s1.y) + (s1.z + s1.w))) + (((s2.x + s2.y) + (s2.z + s2.w)) + ((s3.x + s3.y) + (s3.z + s3.w)));
    const float rs = 1.0f / sqrtf(tot * (1.0f / 1024.0f) + RMS_EPS);
    const f32x4* xr = (const f32x4*)xsrc + lane; const f32x4* gr = (const f32x4*)gpost + lane; const u32x2* tr = (const u32x2*)t + lane;
    f32x4 v[4]; float s = 0.f;
#pragma unroll
    for (int j = 0; j < 4; ++j) { const f32x4 x = xr[64 * j], g = gr[64 * j]; const u32x2 tw = tr[64 * j];
        v[j].x = x.x + bf_lo(tw.x) * rs * g.x; v[j].y = x.y + bf_hi(tw.x) * rs * g.y; v[j].z = x.z + bf_lo(tw.y) * rs * g.z; v[j].w = x.w + bf_hi(tw.y) * rs * g.w;
        s += (v[j].x * v[j].x + v[j].y * v[j].y) + (v[j].z * v[j].z + v[j].w * v[j].w); }
    s = wave_sum(s);
    f32x4* xo = (f32x4*)xdst + lane; u32x2* o8 = (u32x2*)xb + lane;
#pragma unroll
    for (int j = 0; j < 4; ++j) { xo[64 * j] = v[j]; u32x2 w; w.x = cvt_pk_bf16(v[j].x, v[j].y); w.y = cvt_pk_bf16(v[j].z, v[j].w); o8[64 * j] = w; }
    if (lane == 0) *rout = 1.0f / sqrtf(s * (1.0f / 1024.0f) + RMS_EPS);
}

#define MFMA_F16(a, b, c) __builtin_amdgcn_mfma_f32_32x32x16_f16((a), (b), (c), 0, 0, 0)
__device__ __forceinline__ int crow(int reg, int h) { return (reg & 3) + 8 * (reg >> 2) + 4 * h; }
template <bool EARLY_EXIT>
__device__ __forceinline__ void attn_item(const f16_t* Q, const f16_t* Kb, const f16_t* VT, bf16_t* OU, int bh, int qblk, int lane) {
    const int r = lane & 31, hh = lane >> 5;
    const f16_t* qp = Q + ((size_t)bh * 4096 + qblk * 32 + r) * 64 + 8 * hh;
    h16x8 qf[4];
#pragma unroll
    for (int kk = 0; kk < 4; ++kk) qf[kk] = *(const h16x8*)(qp + 16 * kk);
    h16x8 ut[2];
#pragma unroll
    for (int st = 0; st < 2; ++st)
#pragma unroll
        for (int j = 0; j < 8; ++j) ut[st][j] = (crow(8 * st + j, hh) > r) ? (f16_t)1.0f : (f16_t)0.0f;
    f32x16 o0, o1;
#pragma unroll
    for (int i = 0; i < 16; ++i) { o0[i] = 0.f; o1[i] = 0.f; }
    float carry = 0.f;
    for (int kb = qblk; kb >= 0; --kb) {
        const bool diag = (kb == qblk);
        const f16_t* kp = Kb + ((size_t)bh * 4096 + kb * 32 + r) * 64 + 8 * hh;
        h16x8 kf[4];
#pragma unroll
        for (int kk = 0; kk < 4; ++kk) kf[kk] = *(const h16x8*)(kp + 16 * kk);
        const f16_t* vp = VT + ((size_t)bh * 128 + kb) * 2048 + r * 32 + 4 * hh;
        h16x8 vf[2][2];
#pragma unroll
        for (int dh = 0; dh < 2; ++dh)
#pragma unroll
            for (int st = 0; st < 2; ++st) { const h16x4 lo = *(const h16x4*)(vp + dh * 1024 + 16 * st), hi = *(const h16x4*)(vp + dh * 1024 + 16 * st + 8);
                vf[dh][st] = __builtin_shufflevector(lo, hi, 0, 1, 2, 3, 4, 5, 6, 7); }
        f32x16 s;
#pragma unroll
        for (int i = 0; i < 16; ++i) s[i] = 0.f;
#pragma unroll
        for (int kk = 0; kk < 4; ++kk) s = MFMA_F16(kf[kk], qf[kk], s);
        float lsum = 0.f; f32x16 lw; h16x8 Lp[2];
#pragma unroll
        for (int i = 0; i < 16; ++i) {
            const float z = fminf(s[i], 100.0f);
            const float sp = __builtin_amdgcn_logf(1.0f + __builtin_amdgcn_exp2f(z));
            const bool valid = !diag || (crow(i, hh) < r);
            const float L = valid ? -sp : 0.0f;
            lsum += L; lw[i] = z - sp; Lp[i >> 3][i & 7] = (f16_t)L;
        }
        f32x16 later;
#pragma unroll
        for (int i = 0; i < 16; ++i) later[i] = carry;
        later = MFMA_F16(ut[0], Lp[0], later); later = MFMA_F16(ut[1], Lp[1], later);
        h16x8 wp[2];
#pragma unroll
        for (int i = 0; i < 16; ++i) {
            const bool valid = !diag || (crow(i, hh) < r);
            const float w = valid ? __builtin_amdgcn_exp2f(lw[i] + later[i]) : 0.0f;
            wp[i >> 3][i & 7] = (f16_t)w;
        }
        o0 = MFMA_F16(vf[0][0], wp[0], o0); o0 = MFMA_F16(vf[0][1], wp[1], o0);
        o1 = MFMA_F16(vf[1][0], wp[0], o1); o1 = MFMA_F16(vf[1][1], wp[1], o1);
        lsum += __shfl_xor(lsum, 32); carry += lsum;
        if (EARLY_EXIT) { if (__all(carry < -160.0f)) break; }
    }
    const int b = bh >> 3, h = bh & 7;
    bf16_t* op = OU + (size_t)(b * 4096 + qblk * 32 + r) * 1024 + h * 64 + 4 * hh;
#pragma unroll
    for (int g4 = 0; g4 < 4; ++g4) {
        u32x2 w0; w0.x = cvt_pk_bf16(o0[4 * g4 + 0], o0[4 * g4 + 1]); w0.y = cvt_pk_bf16(o0[4 * g4 + 2], o0[4 * g4 + 3]);
        u32x2 w1; w1.x = cvt_pk_bf16(o1[4 * g4 + 0], o1[4 * g4 + 1]); w1.y = cvt_pk_bf16(o1[4 * g4 + 2], o1[4 * g4 + 3]);
        *(u32x2*)(op + 8 * g4) = w0; *(u32x2*)(op + 32 + 8 * g4) = w1;
    }
}
__device__ __forceinline__ void convmix_item(const bf16_t* CCC, const float* cw, bf16_t* OU, int item, int lane) {
    const int r0 = item * 32, c = lane * 8;
    float w0[8], w1[8], w2[8], p1[8], p2[8];
#pragma unroll
    for (int j = 0; j < 8; ++j) { w0[j] = cw[c + j]; w1[j] = cw[512 + c + j]; w2[j] = cw[1024 + c + j]; p1[j] = 0.f; p2[j] = 0.f; }
    const int rstart = ((r0 & 4095) == 0) ? r0 : r0 - 2;
    for (int row = rstart; row < r0 + 32; ++row) {
        const bf16_t* rp = CCC + (size_t)row * 1536 + c;
        const u32x4 cc = *(const u32x4*)(rp + 512), cx = *(const u32x4*)(rp + 1024);
        float p0[8];
#pragma unroll
        for (int q = 0; q < 4; ++q) { p0[2 * q] = bf_lo(cc[q]) * bf_lo(cx[q]); p0[2 * q + 1] = bf_hi(cc[q]) * bf_hi(cx[q]); }
        if (row >= r0) {
            const u32x4 cb = *(const u32x4*)rp; float o[8];
#pragma unroll
            for (int q = 0; q < 4; ++q) {
                o[2 * q] = bf_lo(cb[q]) * (w0[2 * q] * p2[2 * q] + w1[2 * q] * p1[2 * q] + w2[2 * q] * p0[2 * q]);
                o[2 * q + 1] = bf_hi(cb[q]) * (w0[2 * q + 1] * p2[2 * q + 1] + w1[2 * q + 1] * p1[2 * q + 1] + w2[2 * q + 1] * p0[2 * q + 1]);
            }
            u32x4 w; w.x = cvt_pk_bf16(o[0], o[1]); w.y = cvt_pk_bf16(o[2], o[3]); w.z = cvt_pk_bf16(o[4], o[5]); w.w = cvt_pk_bf16(o[6], o[7]);
            *(u32x4*)(OU + (size_t)row * 1024 + 512 + c) = w;
        }
#pragma unroll
        for (int j = 0; j < 8; ++j) { p2[j] = p1[j]; p1[j] = p0[j]; }
    }
}
__device__ __forceinline__ float gelu_tanh(float g) { const float t = 1.5957691216057308f * (g + 0.044715f * g * g * g); return g * __builtin_amdgcn_rcpf(1.0f + __builtin_amdgcn_exp2f(-1.4426950408889634f * t)); }
__device__ __forceinline__ void ffnact_item(const bf16_t* U, const float* cw, bf16_t* ACT, int item, int lane) {
    const int r0 = item * 8;
    for (int cgp = 0; cgp < 6; ++cgp) {
        const int c = cgp * 512 + lane * 8;
        if (c < D_FF) {
            float wa[3][8], wg[3][8], a1[8], a2[8], g1[8], g2[8];
#pragma unroll
            for (int i = 0; i < 3; ++i)
#pragma unroll
                for (int j = 0; j < 8; ++j) { wa[i][j] = cw[i * 2 * D_FF + c + j]; wg[i][j] = cw[i * 2 * D_FF + D_FF + c + j]; }
#pragma unroll
            for (int j = 0; j < 8; ++j) { a1[j] = a2[j] = g1[j] = g2[j] = 0.f; }
            const int rstart = ((r0 & 4095) == 0) ? r0 : r0 - 2;
            for (int row = rstart; row < r0 + 8; ++row) {
                const bf16_t* rp = U + (size_t)row * (2 * D_FF) + c;
                const u32x4 ua = *(const u32x4*)rp, ug = *(const u32x4*)(rp + D_FF);
                float a0[8], g0[8];
#pragma unroll
                for (int q = 0; q < 4; ++q) { a0[2 * q] = bf_lo(ua[q]); a0[2 * q + 1] = bf_hi(ua[q]); g0[2 * q] = bf_lo(ug[q]); g0[2 * q + 1] = bf_hi(ug[q]); }
                if (row >= r0) {
                    float o[8];
#pragma unroll
                    for (int j = 0; j < 8; ++j) {
                        const float av = wa[0][j] * a2[j] + wa[1][j] * a1[j] + wa[2][j] * a0[j];
                        const float gv = wg[0][j] * g2[j] + wg[1][j] * g1[j] + wg[2][j] * g0[j];
                        o[j] = gelu_tanh(gv) * av;
                    }
                    u32x4 w; w.x = cvt_pk_bf16(o[0], o[1]); w.y = cvt_pk_bf16(o[2], o[3]); w.z = cvt_pk_bf16(o[4], o[5]); w.w = cvt_pk_bf16(o[6], o[7]);
                    *(u32x4*)(ACT + (size_t)row * D_FF + c) = w;
                }
#pragma unroll
                for (int j = 0; j < 8; ++j) { a2[j] = a1[j]; a1[j] = a0[j]; g2[j] = g1[j]; g1[j] = g0[j]; }
            }
        }
    }
}


#define XB_TMO      128
#define XB_XCNT(j)  (256  + 64 * (j))
#define XB_XSUB(j)  (1280 + 64 * (j))
#define XB_XGEN(j)  (2304 + 64 * (j))
#define XB_TOP      3328
#define XB_TOPGEN   3392
#define XCD_BAR_WORDS 3456
#define XB_SPIN_CAP (1u << 22)
__device__ __forceinline__ unsigned xb_ld(unsigned* p)              { return __hip_atomic_load(p, __ATOMIC_RELAXED, __HIP_MEMORY_SCOPE_AGENT); }
__device__ __forceinline__ unsigned xb_add(unsigned* p, unsigned v) { return __hip_atomic_fetch_add(p, v, __ATOMIC_RELAXED, __HIP_MEMORY_SCOPE_AGENT); }
__device__ __forceinline__ unsigned xb_xcc_id() { return (unsigned)__builtin_amdgcn_s_getreg((3 << 11) | 20) & 0xFu; }
#define XB_SPIN(cond, bar) do { unsigned _sp = 0; while (cond) { __builtin_amdgcn_s_sleep(1); \
    if ((++_sp & 255u) == 0u) { if (xb_ld(&(bar)[XB_TMO])) break; if (_sp > XB_SPIN_CAP) { atomicAdd(&(bar)[XB_TMO], 1u); break; } } } } while (0)
struct XcdBarrier { unsigned* bar; unsigned x; volatile LAS unsigned* st; };
__device__ __forceinline__ void xcd_barrier_complete(unsigned* bar, unsigned x, unsigned& nloc, unsigned& nx) {
    const unsigned G = gridDim.x * gridDim.y * gridDim.z;
    unsigned sum, cnt, mine, sp = 0u;
    for (;;) {
        sum = 0u; cnt = 0u; mine = 0u;
#pragma unroll
        for (unsigned j = 0; j < 16; ++j) { const unsigned c = xb_ld(&bar[XB_XCNT(j)]); sum += c; cnt += (c > 0u) ? 1u : 0u; mine = (j == x) ? c : mine; }
        if (sum == G) break;
        __builtin_amdgcn_s_sleep(1);
        if ((++sp & 255u) == 0u) { if (xb_ld(&bar[XB_TMO])) break; if (sp > XB_SPIN_CAP) { atomicAdd(&bar[XB_TMO], 1u); break; } }
    }
    nloc = mine > 0u ? mine : 1u; nx = cnt > 0u ? cnt : 1u;
}
__device__ __forceinline__ void xcd_barrier(const XcdBarrier& b) {
    asm volatile("s_waitcnt vmcnt(0)" ::: "memory");
    __syncthreads();
    if (threadIdx.x == 0) {
        unsigned* bar = b.bar;
        __builtin_amdgcn_s_waitcnt(0);
        unsigned nloc = b.st[0], nx = b.st[1];
        if (nloc == 0u) { xcd_barrier_complete(bar, b.x, nloc, nx); b.st[0] = nloc; b.st[1] = nx; }
        const unsigned old = xb_add(&bar[XB_XSUB(b.x)], 1u);
        const unsigned gen = old / nloc;
        if (old + 1u == (gen + 1u) * nloc) {
            __builtin_amdgcn_fence(__ATOMIC_RELEASE, "agent");
            asm volatile("s_waitcnt vmcnt(0)" ::: "memory");
            const unsigned og = xb_add(&bar[XB_TOP], 1u);
            const unsigned tg = og / nx;
            if (og + 1u == (tg + 1u) * nx) xb_add(&bar[XB_TOPGEN], 1u);
            else XB_SPIN(xb_ld(&bar[XB_TOPGEN]) == tg, bar);
            __builtin_amdgcn_fence(__ATOMIC_ACQUIRE, "agent");
            xb_add(&bar[XB_XGEN(b.x)], 1u);
            asm volatile("s_waitcnt vmcnt(0)" ::: "memory");
        } else {
            XB_SPIN(xb_ld(&bar[XB_XGEN(b.x)]) == gen, bar);
            __builtin_amdgcn_fence(__ATOMIC_ACQUIRE, "agent");
            asm volatile("s_waitcnt vmcnt(0)" ::: "memory");
        }
    }
    __syncthreads();
}


#ifndef STOP_AFTER
#define STOP_AFTER -1
#endif
__device__ __forceinline__ void dbg_dump(float* out, const bf16_t* buf, size_t count) {
    const size_t tot = (size_t)gridDim.x * 512, i0 = (size_t)blockIdx.x * 512 + threadIdx.x;
    for (size_t i = i0; i < (size_t)MTOT * D_MODEL; i += tot) out[i] = i < count ? __uint_as_float((unsigned)buf[i] << 16) : 0.0f;
}
#define DBG_STOP(k, off, count) do { if (STOP_AFTER == (k) && hl == 0) { dbg_dump(a.out, (const bf16_t*)(a.ws + (off)), (count)); return; } } while (0)
struct Args { const float* in[13]; float* out; unsigned char* ws; };
#ifndef ATT_EARLY_EXIT
#define ATT_EARLY_EXIT false
#endif

#define LAUNDER_S(p) asm volatile("" : "+s"(p))
#define LAUNDER_V(v) asm volatile("" : "+v"(v))
#define PHASE_BEGIN() unsigned char* ws = a.ws; LAUNDER_S(ws); int lane; asm volatile("v_mbcnt_lo_u32_b32 %0, -1, 0\n\tv_mbcnt_hi_u32_b32 %0, -1, %0" : "=v"(lane)); \
    int wave = wave0; LAUNDER_S(wave); const int G = gridDim.x, gw = blockIdx.x * 8 + wave, NGW = G * 8; (void)gw; (void)NGW; (void)lane; \
    unsigned char* wl = ws + WS_W + (size_t)l * W_LAYER; (void)wl

__global__ void __launch_bounds__(512, 2) hybrid_fwd(Args a) {
    extern __shared__ __attribute__((aligned(16))) unsigned char lds_raw[];
    LAS unsigned char* lds = (LAS unsigned char*)lds_raw;
    cg::grid_group grid = cg::this_grid();
    const int wave0 = __builtin_amdgcn_readfirstlane(threadIdx.x >> 6);
    if (threadIdx.x < 4) ((volatile LAS unsigned*)(lds + 131072))[threadIdx.x] = 0u;
    __syncthreads();
    if (threadIdx.x == 0) (void)xb_add((unsigned*)a.ws + XB_XCNT(xb_xcc_id()), 1u);
#define GRID_SYNC() do { XcdBarrier _b; _b.bar = (unsigned*)a.ws; _b.x = xb_xcc_id(); _b.st = (volatile LAS unsigned*)(lds + 131072); xcd_barrier(_b); } while (0)

    for (int hl = 0; hl < NHALF * DEPTH; ++hl) {
        const int half = hl / DEPTH, l = hl % DEPTH;
        const size_t xoff = (size_t)half * MH * D_MODEL;
        if (l == 0) {
            PHASE_BEGIN();
            if (half == 0) {
                LAS float* scr = (LAS float*)(lds + wave * 16384);
                constexpr int I_IN = 16 * (IN_COLS / 32), I_BR = 8 * 32, I_OUT = 16 * 32, I_UP = 16 * (2 * D_FF / 32), I_DN = (D_FF / 64) * 32, I_L = I_IN + 2 * I_BR + I_OUT + I_UP + I_DN;
                for (int it = gw; it < DEPTH * I_L; it += NGW) {
                    const int ll = it / I_L; int r = it % I_L;
                    unsigned char* wll = ws + WS_W + (size_t)ll * W_LAYER;
                    if (r < I_IN) { tr_item(a.in[2] + (size_t)ll * 1024 * IN_COLS, IN_COLS, a.in[1] + ll * 1024, (bf16_t*)(wll + W_IN), 1024, 0, scr, r, lane); continue; } r -= I_IN;
                    if (r < I_BR) { tr_item(a.in[4] + (size_t)ll * 512 * 1024, 1024, nullptr, (bf16_t*)(wll + W_BR), 1024, 0, scr, r, lane); continue; } r -= I_BR;
                    if (r < I_BR) { tr_item(a.in[5] + (size_t)ll * 512 * 1024, 1024, nullptr, (bf16_t*)(wll + W_BR), 1024, 512, scr, r, lane); continue; } r -= I_BR;
                    if (r < I_OUT) { tr_item(a.in[6] + (size_t)ll * 1024 * 1024, 1024, nullptr, (bf16_t*)(wll + W_OUT), 1024, 0, scr, r, lane); continue; } r -= I_OUT;
                    if (r < I_UP) { tr_item(a.in[9] + (size_t)ll * 1024 * 2 * D_FF, 2 * D_FF, a.in[8] + ll * 1024, (bf16_t*)(wll + W_UP), 1024, 0, scr, r, lane); continue; } r -= I_UP;
                    tr_item(a.in[11] + (size_t)ll * D_FF * 1024, 1024, nullptr, (bf16_t*)(wll + W_DN), D_FF, 0, scr, r, lane);
                }
            }
            for (int m = gw; m < MH; m += NGW) pro_row(a.in[0] + xoff + (size_t)m * 1024, (bf16_t*)(ws + WS_XB) + (size_t)m * 1024, (float*)(ws + WS_R) + m, lane);
            GRID_SYNC();
        }
        { PHASE_BEGIN();
          pg8::Gemm g{(const bf16_t*)(ws + WS_XB), (const bf16_t*)(wl + W_IN), MH, IN_COLS, 1024}; pg8::StaticOrder S; S.init(MH, IN_COLS, G, (int)blockIdx.x);
          pg8::EpiIn E{(const float*)(ws + WS_R), (f16_t*)(ws + WS_Q), (f16_t*)(ws + WS_K), (f16_t*)(ws + WS_VT), (bf16_t*)(ws + WS_CCC), (bf16_t*)(ws + WS_G)};
          pg8::gemm_phase<pg8::EpiIn>(lds, g, S, E, wave, lane); }
        GRID_SYNC();
        DBG_STOP(1, WS_G, (size_t)MH * 2048);
        { PHASE_BEGIN();
          const f16_t* Qb = (const f16_t*)(ws + WS_Q); const f16_t* Kb = (const f16_t*)(ws + WS_K); const f16_t* VT = (const f16_t*)(ws + WS_VT); bf16_t* OU = (bf16_t*)(ws + WS_OU);
          for (int it = gw; it < 32 * 64; it += NGW) {
              const int bh = it >> 6, i = it & 63;
              attn_item<ATT_EARLY_EXIT>(Qb, Kb, VT, OU, bh, 127 - i, lane);
              attn_item<ATT_EARLY_EXIT>(Qb, Kb, VT, OU, bh, i, lane);
          }
          for (int it = gw; it < MH / 32; it += NGW) convmix_item((const bf16_t*)(ws + WS_CCC), a.in[3] + (size_t)l * 3 * CONVW, OU, it, lane); }
        GRID_SYNC();
        DBG_STOP(2, WS_OU, (size_t)MH * 1024);
        { PHASE_BEGIN();
          pg8::Gemm g{(const bf16_t*)(ws + WS_OU), (const bf16_t*)(wl + W_BR), MH, 1024, 1024}; pg8::StaticOrder S; S.init(MH, 1024, G, (int)blockIdx.x);
          pg8::EpiMerge E{(const bf16_t*)(ws + WS_G), (bf16_t*)(ws + WS_MG)}; pg8::gemm_phase<pg8::EpiMerge>(lds, g, S, E, wave, lane); }
        GRID_SYNC();
        DBG_STOP(3, WS_MG, (size_t)MH * 1024);
        { PHASE_BEGIN();
          pg8::Gemm g{(const bf16_t*)(ws + WS_MG), (const bf16_t*)(wl + W_OUT), MH, 1024, 1024}; pg8::StaticOrder S; S.init(MH, 1024, G, (int)blockIdx.x);
          pg8::EpiNormOut E{(bf16_t*)(ws + WS_T), (float*)(ws + WS_SSQ)}; pg8::gemm_phase<pg8::EpiNormOut>(lds, g, S, E, wave, lane); }
        GRID_SYNC();
        DBG_STOP(4, WS_T, (size_t)MH * 1024);
        { PHASE_BEGIN();
          const float* xs = (l == 0 ? a.in[0] : a.out) + xoff;
          for (int m = gw; m < MH; m += NGW) res_row(xs + (size_t)m * 1024, a.out + xoff + (size_t)m * 1024, (const bf16_t*)(ws + WS_T) + (size_t)m * 1024, (const float*)(ws + WS_SSQ) + (size_t)m * 16,
                                                     a.in[7] + l * 1024, (bf16_t*)(ws + WS_XB) + (size_t)m * 1024, (float*)(ws + WS_R) + m, lane); }
        GRID_SYNC();
        DBG_STOP(5, WS_XB, (size_t)MH * 1024);
        { PHASE_BEGIN();
          pg8::Gemm g{(const bf16_t*)(ws + WS_XB), (const bf16_t*)(wl + W_UP), MH, 2 * D_FF, 1024}; pg8::StaticOrder S; S.init(MH, 2 * D_FF, G, (int)blockIdx.x);
          pg8::EpiScale E{(const float*)(ws + WS_R), (bf16_t*)(ws + WS_U), 2 * D_FF}; pg8::gemm_phase<pg8::EpiScale>(lds, g, S, E, wave, lane); }
        GRID_SYNC();
        DBG_STOP(6, WS_U, (size_t)MH * 2048);
        { PHASE_BEGIN();
          for (int it = gw; it < MH / 8; it += NGW) ffnact_item((const bf16_t*)(ws + WS_U), a.in[10] + (size_t)l * 3 * 2 * D_FF, (bf16_t*)(ws + WS_ACT), it, lane); }
        GRID_SYNC();
        DBG_STOP(7, WS_ACT, (size_t)MH * 2048);
        { PHASE_BEGIN();
          pg8::Gemm g{(const bf16_t*)(ws + WS_ACT), (const bf16_t*)(wl + W_DN), MH, 1024, D_FF}; pg8::StaticOrder S; S.init(MH, 1024, G, (int)blockIdx.x);
          pg8::EpiNormOut E{(bf16_t*)(ws + WS_F), (float*)(ws + WS_SSQ)}; pg8::gemm_phase<pg8::EpiNormOut>(lds, g, S, E, wave, lane); }
        GRID_SYNC();
        DBG_STOP(8, WS_F, (size_t)MH * 1024);
        { PHASE_BEGIN();
          for (int m = gw; m < MH; m += NGW) res_row(a.out + xoff + (size_t)m * 1024, a.out + xoff + (size_t)m * 1024, (const bf16_t*)(ws + WS_F) + (size_t)m * 1024, (const float*)(ws + WS_SSQ) + (size_t)m * 16,
                                                     a.in[12] + l * 1024, (bf16_t*)(ws + WS_XB) + (size_t)m * 1024, (float*)(ws + WS_R) + m, lane); }
        GRID_SYNC();
    }
    grid.sync();
}

extern "C" void kernel_launch(void* const* d_in, const int* in_sizes, int n_in, void* d_out, int out_size, void* d_ws, size_t ws_size, hipStream_t stream) {
    static int grid = 0;
    if (grid == 0) {
        if (n_in != 13 || in_sizes[0] != MTOT * D_MODEL || out_size != MTOT * D_MODEL || ws_size < WS_END) {
            fprintf(stderr, "kernel_launch: unexpected shapes (n_in %d, in0 %d, out %d, ws %zu)\n", n_in, n_in > 0 ? in_sizes[0] : -1, out_size, ws_size); grid = -1; return; }
        int dev = 0, cus = 0, per_cu = 0;
        (void)hipGetDevice(&dev);
        (void)hipDeviceGetAttribute(&cus, hipDeviceAttributeMultiprocessorCount, dev);
        (void)hipFuncSetAttribute((const void*)hybrid_fwd, hipFuncAttributeMaxDynamicSharedMemorySize, LDS_BYTES);
        if (hipOccupancyMaxActiveBlocksPerMultiprocessor(&per_cu, (const void*)hybrid_fwd, 512, LDS_BYTES) != hipSuccess || per_cu < 1) per_cu = 1;
        (void)hipGetLastError();
        grid = cus * per_cu;
    }
    if (grid < 0) return;
    if (hipMemsetAsync(d_ws, 0, 16384, stream) != hipSuccess) { fprintf(stderr, "kernel_launch: memset of the barrier words failed\n"); return; }
    Args a{};
    for (int i = 0; i < 13; ++i) a.in[i] = (const float*)d_in[i];
    a.out = (float*)d_out; a.ws = (unsigned char*)d_ws;
    void* args[] = {&a};
    hipError_t e = hipLaunchCooperativeKernel((const void*)hybrid_fwd, dim3(grid), dim3(512), args, LDS_BYTES, stream);
    if (e != hipSuccess) fprintf(stderr, "cooperative launch failed: %s (grid %d)\n", hipGetErrorString(e), grid);
}
```

```cpp
#include <hip/hip_runtime.h>
#include <hip/hip_cooperative_groups.h>
#include <cstdio>
#include <cstdint>
namespace cg = cooperative_groups;

#define LAS __attribute__((address_space(3)))
typedef unsigned short bf16_t;
typedef _Float16 f16_t;
typedef short bf16x8 __attribute__((ext_vector_type(8)));
typedef float f32x4 __attribute__((ext_vector_type(4)));
typedef float f32x16 __attribute__((ext_vector_type(16)));
typedef unsigned u32x4 __attribute__((ext_vector_type(4)));
typedef unsigned u32x2 __attribute__((ext_vector_type(2)));
typedef _Float16 h16x8 __attribute__((ext_vector_type(8)));
typedef _Float16 h16x4 __attribute__((ext_vector_type(4)));

constexpr int D_MODEL = 1024, BATCH = 8, SEQ = 4096, DEPTH = 4, NHEAD = 8, HDIM = 64, ATTW = 512, CONVW = 512, D_FF = 2816, IN_COLS = 5120;
constexpr int MTOT = BATCH * SEQ;
constexpr int NHALF = 2, MH = MTOT / NHALF;
constexpr float RMS_EPS = 1e-6f;
constexpr float QSCALE = 0.18033688011112042f;

constexpr size_t MiB = 1u << 20;
constexpr size_t WS_R = 1 * MiB;
constexpr size_t WS_W = 2 * MiB;
constexpr size_t W_IN = 0, W_BR = W_IN + (size_t)IN_COLS * 1024 * 2, W_OUT = W_BR + 2 * MiB, W_UP = W_OUT + 2 * MiB, W_DN = W_UP + (size_t)2 * D_FF * 1024 * 2, W_LAYER = W_DN + (size_t)1024 * D_FF * 2;
static_assert(W_LAYER == 31981568, "weights per layer");
constexpr size_t WS_XB = 124 * MiB;
constexpr size_t WS_SSQ = 156 * MiB;
constexpr size_t WS_Q = 158 * MiB, WS_K = 174 * MiB, WS_VT = 190 * MiB, WS_CCC = 206 * MiB, WS_G = 254 * MiB, WS_OU = 318 * MiB, WS_MG = 350 * MiB, WS_T = 382 * MiB;
constexpr size_t WS_U = 158 * MiB, WS_ACT = 334 * MiB, WS_F = 422 * MiB, WS_END = 454 * MiB;
static_assert(WS_W + 4 * W_LAYER <= WS_XB, "weights fit");
static_assert(WS_U + (size_t)MH * 2 * D_FF * 2 <= WS_ACT && WS_ACT + (size_t)MH * D_FF * 2 <= WS_F, "ffn map");

constexpr int LDS_BYTES = 147456;

namespace pg8 {
constexpr int BM = 256, BK = 64, HALF = 128, HTB = HALF * BK * 2, STAGE_BYTES = 8 * HTB, NXCD = 8, WGM = 8;
__host__ __device__ __forceinline__ int lds_byte(int r, int c) { const int st = (r >> 4) * 2 + (c >> 5), rr = r & 15, cc = c & 31, ob = rr * 64 + cc * 2; return st * 1024 + (ob ^ (((ob >> 9) & 1) << 5)); }
__host__ __device__ __forceinline__ void stage_rc(int b, int& R, int& C) { const int st = b / 1024, sb = b % 1024, swz = sb ^ (((sb >> 9) & 1) << 5); R = (st >> 1) * 16 + swz / 64; C = (st & 1) * 32 + (swz % 64) / 2; }
__host__ __device__ __forceinline__ int perm32(int rho) { const int n = rho >> 4, i = rho & 15; return 8 * (i >> 2) + 4 * n + (i & 3); }

struct Unit { int pm, pn; };
struct Gemm { const bf16_t* A; const bf16_t* Bt; int M, N, K; };
struct StaticOrder {
    int nM, nN, nwg, G, c;
    __device__ void init(int M, int N, int G_, int c_) { nM = M / BM; nN = N / BM; nwg = nM * nN; G = G_; c = c_; }
    __device__ bool next(int i, Unit& u) const {
        const long L = (long)i * G + c; if (L >= nwg) return false;
        int wgid = (int)L; { const int q = nwg / NXCD, r = nwg % NXCD, xcd = wgid % NXCD, off = wgid / NXCD; wgid = (xcd < r ? xcd * (q + 1) : r * (q + 1) + (xcd - r) * q) + off; }
        const int nig = WGM * nN, gid = wgid / nig, fm = gid * WGM, gsz = (nM - fm) < WGM ? (nM - fm) : WGM;
        u.pm = fm + ((wgid % nig) % gsz); u.pn = (wgid % nig) / gsz; return true;
    }
};

typedef __bf16 bf16x2_v __attribute__((ext_vector_type(2)));
typedef float f32x2_v __attribute__((ext_vector_type(2)));
__device__ __forceinline__ unsigned cvt_pk_bf16(float lo, float hi) { const f32x2_v f = {lo, hi}; const bf16x2_v r = __builtin_convertvector(f, bf16x2_v); return __builtin_bit_cast(unsigned, r); }
__device__ __forceinline__ u32x4 pack8_bf16(f32x4 v0, f32x4 v1) { u32x4 w; w.x = cvt_pk_bf16(v0[0], v0[1]); w.y = cvt_pk_bf16(v0[2], v0[3]); w.z = cvt_pk_bf16(v1[0], v1[1]); w.w = cvt_pk_bf16(v1[2], v1[3]); return w; }
__device__ __forceinline__ float bf_lo(unsigned w) { return __uint_as_float(w << 16); }
__device__ __forceinline__ float bf_hi(unsigned w) { return __uint_as_float(w & 0xffff0000u); }
__device__ __forceinline__ float sigmoidf_(float x) { return __builtin_amdgcn_rcpf(1.0f + __builtin_amdgcn_exp2f(-1.4426950408889634f * x)); }


struct EpiIn {
    static constexpr bool PERM = true, HAS_MID = false;
    const float* rs; f16_t* Q; f16_t* Kb; f16_t* VT; bf16_t* CCC; bf16_t* G;
    __device__ __forceinline__ void mid(f32x4 (&)[2][2][4][2], const Unit&, int, int, int, int) const {}
    __device__ __forceinline__ void operator()(const f32x4 (&acc)[2][2][4][2], const Unit& u, int wr, int wc, int fr, int fq) const {
        asm volatile("" : "+v"(fr), "+v"(fq));
        const int pn = u.pn, row0 = u.pm * BM + wr * 64 + fr;
#pragma unroll
        for (int ai = 0; ai < 2; ++ai)
#pragma unroll
            for (int m = 0; m < 4; ++m) {
                const int r = row0 + ai * HALF + m * 16; const float sc = rs[r]; const int b = r >> 12, s = r & 4095;
#pragma unroll
                for (int bj = 0; bj < 2; ++bj) {
                    const int c = pn * 256 + bj * HALF + wc * 32 + 8 * fq;
                    f32x4 v0 = acc[ai][bj][m][0] * sc, v1 = acc[ai][bj][m][1] * sc;
                    if (pn < 4) {
                        const int cc = c & 511, head = cc >> 6, d = cc & 63;
                        if (pn < 2) { v0 = v0 * QSCALE; v1 = v1 * QSCALE; }
                        h16x8 o; o[0] = (f16_t)v0[0]; o[1] = (f16_t)v0[1]; o[2] = (f16_t)v0[2]; o[3] = (f16_t)v0[3]; o[4] = (f16_t)v1[0]; o[5] = (f16_t)v1[1]; o[6] = (f16_t)v1[2]; o[7] = (f16_t)v1[3];
                        f16_t* base = (pn < 2 ? Q : Kb) + ((size_t)((b * 8 + head) * 4096 + s) * 64 + d);
                        *(h16x8*)base = o;
                    } else if (pn < 6) {
                        const int cc = c - 1024, head = cc >> 6, d = cc & 63;
                        f16_t* base = VT + ((size_t)(((b * 8 + head) * 128 + (s >> 5)) * 64 + d) * 32 + (s & 31));
                        base[0 * 32] = (f16_t)v0[0]; base[1 * 32] = (f16_t)v0[1]; base[2 * 32] = (f16_t)v0[2]; base[3 * 32] = (f16_t)v0[3];
                        base[4 * 32] = (f16_t)v1[0]; base[5 * 32] = (f16_t)v1[1]; base[6 * 32] = (f16_t)v1[2]; base[7 * 32] = (f16_t)v1[3];
                    } else if (pn < 12) {
                        *(u32x4*)(CCC + (size_t)r * 1536 + (c - 1536)) = pack8_bf16(v0, v1);
                    } else {
#pragma unroll
                        for (int j = 0; j < 4; ++j) { v0[j] = sigmoidf_(v0[j]); v1[j] = sigmoidf_(v1[j]); }
                        *(u32x4*)(G + (size_t)r * 2048 + (c - 3072)) = pack8_bf16(v0, v1);
                    }
                }
            }
    }
};
struct EpiMerge {
    static constexpr bool PERM = true, HAS_MID = true;
    const bf16_t* G; bf16_t* O;
    __device__ __forceinline__ void mid(f32x4 (&acc)[2][2][4][2], const Unit& u, int wr, int wc, int fr, int fq) const {
        asm volatile("" : "+v"(fr), "+v"(fq));
        const int row0 = u.pm * BM + wr * 64 + fr;
#pragma unroll
        for (int ai = 0; ai < 2; ++ai)
#pragma unroll
            for (int m = 0; m < 4; ++m) {
                const int r = row0 + ai * HALF + m * 16;
#pragma unroll
                for (int bj = 0; bj < 2; ++bj) {
                    const int c = u.pn * 256 + bj * HALF + wc * 32 + 8 * fq;
                    const u32x4 ga = *(const u32x4*)(G + (size_t)r * 2048 + c), gc = *(const u32x4*)(G + (size_t)r * 2048 + 1024 + c);
#pragma unroll
                    for (int q = 0; q < 4; ++q) {
                        const float a0 = bf_lo(ga[q]), a1 = bf_hi(ga[q]), c0 = fmaxf(bf_lo(gc[q]), 1e-20f), c1 = fmaxf(bf_hi(gc[q]), 1e-20f);
                        acc[ai][bj][m][q >> 1][(q & 1) * 2 + 0] *= a0 * __builtin_amdgcn_rcpf(c0);
                        acc[ai][bj][m][q >> 1][(q & 1) * 2 + 1] *= a1 * __builtin_amdgcn_rcpf(c1);
                    }
                }
            }
    }
    __device__ __forceinline__ void operator()(const f32x4 (&acc)[2][2][4][2], const Unit& u, int wr, int wc, int fr, int fq) const {
        asm volatile("" : "+v"(fr), "+v"(fq));
        const int row0 = u.pm * BM + wr * 64 + fr;
#pragma unroll
        for (int ai = 0; ai < 2; ++ai)
#pragma unroll
            for (int m = 0; m < 4; ++m) {
                const int r = row0 + ai * HALF + m * 16;
#pragma unroll
                for (int bj = 0; bj < 2; ++bj) {
                    const int c = u.pn * 256 + bj * HALF + wc * 32 + 8 * fq;
                    const u32x4 gc = *(const u32x4*)(G + (size_t)r * 2048 + 1024 + c);
                    f32x4 v0 = acc[ai][bj][m][0], v1 = acc[ai][bj][m][1];
                    v0[0] *= fmaxf(bf_lo(gc[0]), 1e-20f); v0[1] *= fmaxf(bf_hi(gc[0]), 1e-20f); v0[2] *= fmaxf(bf_lo(gc[1]), 1e-20f); v0[3] *= fmaxf(bf_hi(gc[1]), 1e-20f);
                    v1[0] *= fmaxf(bf_lo(gc[2]), 1e-20f); v1[1] *= fmaxf(bf_hi(gc[2]), 1e-20f); v1[2] *= fmaxf(bf_lo(gc[3]), 1e-20f); v1[3] *= fmaxf(bf_hi(gc[3]), 1e-20f);
                    *(u32x4*)(O + (size_t)r * 1024 + c) = pack8_bf16(v0, v1);
                }
            }
    }
};
struct EpiNormOut {
    static constexpr bool PERM = true, HAS_MID = false;
    bf16_t* O; float* ssq;
    __device__ __forceinline__ void mid(f32x4 (&)[2][2][4][2], const Unit&, int, int, int, int) const {}
    __device__ __forceinline__ void operator()(const f32x4 (&acc)[2][2][4][2], const Unit& u, int wr, int wc, int fr, int fq) const {
        asm volatile("" : "+v"(fr), "+v"(fq));
        const int row0 = u.pm * BM + wr * 64 + fr;
#pragma unroll
        for (int ai = 0; ai < 2; ++ai)
#pragma unroll
            for (int m = 0; m < 4; ++m) {
                const int r = row0 + ai * HALF + m * 16; float q = 0.f;
#pragma unroll
                for (int bj = 0; bj < 2; ++bj) {
                    const int c = u.pn * 256 + bj * HALF + wc * 32 + 8 * fq;
                    const f32x4 v0 = acc[ai][bj][m][0], v1 = acc[ai][bj][m][1];
                    q += (v0[0] * v0[0] + v0[1] * v0[1]) + (v0[2] * v0[2] + v0[3] * v0[3]) + (v1[0] * v1[0] + v1[1] * v1[1]) + (v1[2] * v1[2] + v1[3] * v1[3]);
                    *(u32x4*)(O + (size_t)r * 1024 + c) = pack8_bf16(v0, v1);
                }
                q += __shfl_xor(q, 16); q += __shfl_xor(q, 32);
                if (fq == 0) ssq[(size_t)r * 16 + u.pn * 4 + wc] = q;
            }
    }
};
struct EpiScale {
    static constexpr bool PERM = true, HAS_MID = false;
    const float* rs; bf16_t* O; int ldc;
    __device__ __forceinline__ void mid(f32x4 (&)[2][2][4][2], const Unit&, int, int, int, int) const {}
    __device__ __forceinline__ void operator()(const f32x4 (&acc)[2][2][4][2], const Unit& u, int wr, int wc, int fr, int fq) const {
        asm volatile("" : "+v"(fr), "+v"(fq));
        const int row0 = u.pm * BM + wr * 64 + fr;
#pragma unroll
        for (int ai = 0; ai < 2; ++ai)
#pragma unroll
            for (int m = 0; m < 4; ++m) {
                const int r = row0 + ai * HALF + m * 16; const float sc = rs[r];
#pragma unroll
                for (int bj = 0; bj < 2; ++bj) {
                    const int c = u.pn * 256 + bj * HALF + wc * 32 + 8 * fq;
                    *(u32x4*)(O + (size_t)r * ldc + c) = pack8_bf16(acc[ai][bj][m][0] * sc, acc[ai][bj][m][1] * sc);
                }
            }
    }
};

template <class Epi>
__device__ __forceinline__ void gemm_phase(LAS unsigned char* lds, const Gemm g, const StaticOrder& S, const Epi& E, const int wid, const int lane) {
    const int tid = wid * 64 + lane, wr = wid >> 2, wc = wid & 3, fr = lane & 15, fq = lane >> 4;
    const int K = g.K, nt = K / BK;
    unsigned voffA[2], voffB[2];
#pragma unroll
    for (int i = 0; i < 2; ++i) { int R, C; stage_rc(tid * 16 + i * 8192, R, C); const int Rb = Epi::PERM ? ((R & ~31) + perm32(R & 31)) : R;
        voffA[i] = (unsigned)(R * K + C) * 2u; voffB[i] = (unsigned)(Rb * K + C) * 2u; }
    const size_t kstep = (size_t)(BK * 2);
    const size_t hstep = (size_t)HALF * K * 2;
    const size_t tstep = 2 * hstep;
    const unsigned ldsw = (unsigned)wid * 1024u;
    const int aoff = lds_byte(wr * 64 + fr, fq * 8), boff = lds_byte(wc * 32 + fr, fq * 8);
#define PG8_SA(b, h) (((b) * 2 + (h)) * HTB)
#define PG8_SB(b, h) ((4 + (b) * 2 + (h)) * HTB)
#define PG8_STAGE(bufoff, gbase, voff) do { _Pragma("unroll") for (int _i = 0; _i < 2; ++_i) \
        __builtin_amdgcn_global_load_lds((const unsigned*)((const char*)(gbase) + (voff)[_i]), (LAS unsigned*)(lds + (bufoff) + ldsw + _i * 8192), 16, 0, 0); } while (0)
#define PG8_LDA(dst, b, h) do { _Pragma("unroll") for (int m = 0; m < 4; ++m) _Pragma("unroll") for (int k = 0; k < 2; ++k) dst[m][k] = *(const LAS bf16x8*)(lds + PG8_SA(b, h) + aoff + m * 2048 + k * 1024); } while (0)
#define PG8_LDB(dst, b, h) do { _Pragma("unroll") for (int n = 0; n < 2; ++n) _Pragma("unroll") for (int k = 0; k < 2; ++k) dst[n][k] = *(const LAS bf16x8*)(lds + PG8_SB(b, h) + boff + n * 2048 + k * 1024); } while (0)
#define PG8_MMA(ai, bj, At, Bt) do { __builtin_amdgcn_s_setprio(1); _Pragma("unroll") for (int m = 0; m < 4; ++m) _Pragma("unroll") for (int n = 0; n < 2; ++n) _Pragma("unroll") for (int k = 0; k < 2; ++k) \
        acc[ai][bj][m][n] = __builtin_amdgcn_mfma_f32_16x16x32_bf16(Bt[n][k], At[m][k], acc[ai][bj][m][n], 0, 0, 0); __builtin_amdgcn_s_setprio(0); } while (0)
#define PG8_WAIT_V(n) asm volatile("s_waitcnt vmcnt(" #n ")" ::: "memory")
#define PG8_WAIT_L(n) asm volatile("s_waitcnt lgkmcnt(" #n ")" ::: "memory")
#define PG8_BAR __builtin_amdgcn_s_barrier()
#define PG8_SCHED __builtin_amdgcn_sched_barrier(0)
    Unit cur, nxt; int ui = 0;
    if (!S.next(0, cur)) return;
    f32x4 acc[2][2][4][2];
#pragma unroll
    for (int a = 0; a < 2; ++a)
#pragma unroll
        for (int b = 0; b < 2; ++b)
#pragma unroll
            for (int m = 0; m < 4; ++m)
#pragma unroll
                for (int n = 0; n < 2; ++n) acc[a][b][m][n] = (f32x4){0.f, 0.f, 0.f, 0.f};
    bf16x8 At[4][2], B0[2][2], B1[2][2];
    const char* cA = (const char*)g.A + (size_t)cur.pm * tstep; const char* cB = (const char*)g.Bt + (size_t)cur.pn * tstep;
    PG8_STAGE(PG8_SB(0, 0), cB, voffB); PG8_STAGE(PG8_SB(0, 1), cB + hstep, voffB); PG8_STAGE(PG8_SA(0, 0), cA, voffA); PG8_STAGE(PG8_SA(0, 1), cA + hstep, voffA);
    if (wr == 1) PG8_BAR;
    PG8_WAIT_V(2); PG8_BAR;
    PG8_STAGE(PG8_SB(1, 0), cB + kstep, voffB); PG8_STAGE(PG8_SA(1, 0), cA + kstep, voffA); PG8_STAGE(PG8_SB(1, 1), cB + hstep + kstep, voffB);
    PG8_WAIT_V(6); PG8_BAR;
    for (;;) {
        const bool has_next = S.next(ui + 1, nxt);
        const char* nA = has_next ? (const char*)g.A + (size_t)nxt.pm * tstep : cA; const char* nB = has_next ? (const char*)g.Bt + (size_t)nxt.pn * tstep : cB;
        for (int t = 0; t < nt; t += 2) {
            const bool last = (t == nt - 2);
            const char* a1 = cA + (size_t)(t + 1) * kstep;
            const char* a2 = last ? nA : cA + (size_t)(t + 2) * kstep; const char* b2 = last ? nB : cB + (size_t)(t + 2) * kstep;
            const char* a3 = a2 + kstep; const char* b3 = b2 + kstep;
            if constexpr (Epi::HAS_MID) { if (t == (nt >> 1)) E.mid(acc, cur, wr, wc, fr, fq); }
            PG8_LDB(B0, 0, 0); PG8_LDB(B1, 0, 1); PG8_SCHED; PG8_LDA(At, 0, 0); PG8_STAGE(PG8_SA(1, 1), a1 + hstep, voffA);
            PG8_WAIT_V(8); PG8_WAIT_L(0); PG8_BAR; PG8_MMA(0, 0, At, B0); PG8_MMA(0, 1, At, B1); PG8_BAR; PG8_SCHED;
            PG8_LDA(At, 0, 1); PG8_STAGE(PG8_SB(0, 0), b2, voffB); PG8_STAGE(PG8_SB(0, 1), b2 + hstep, voffB); PG8_STAGE(PG8_SA(0, 0), a2, voffA);
            PG8_WAIT_V(8); PG8_WAIT_L(0); PG8_BAR; PG8_MMA(1, 0, At, B0); PG8_MMA(1, 1, At, B1); PG8_BAR; PG8_SCHED;
            PG8_LDB(B0, 1, 0); PG8_LDB(B1, 1, 1); PG8_SCHED; PG8_LDA(At, 1, 0); PG8_STAGE(PG8_SA(0, 1), a2 + hstep, voffA);
            PG8_WAIT_V(8); PG8_WAIT_L(0); PG8_BAR; PG8_MMA(0, 0, At, B0); PG8_MMA(0, 1, At, B1); PG8_BAR; PG8_SCHED;
            PG8_LDA(At, 1, 1); PG8_STAGE(PG8_SB(1, 0), b3, voffB); PG8_STAGE(PG8_SB(1, 1), b3 + hstep, voffB); PG8_STAGE(PG8_SA(1, 0), a3, voffA);
            PG8_WAIT_V(8); PG8_WAIT_L(0); PG8_BAR; PG8_MMA(1, 0, At, B0); PG8_MMA(1, 1, At, B1); PG8_BAR; PG8_SCHED;
        }
        if (wr == 0) PG8_BAR;
        E(acc, cur, wr, wc, fr, fq);
        if (!has_next) break;
#pragma unroll
        for (int a = 0; a < 2; ++a)
#pragma unroll
            for (int b = 0; b < 2; ++b)
#pragma unroll
                for (int m = 0; m < 4; ++m)
#pragma unroll
                    for (int n = 0; n < 2; ++n) acc[a][b][m][n] = (f32x4){0.f, 0.f, 0.f, 0.f};
        cur = nxt; cA = nA; cB = nB; ++ui;
        if (wr == 1) PG8_BAR;
    }
    PG8_WAIT_V(0);
    PG8_BAR;
#undef PG8_SA
#undef PG8_SB
#undef PG8_STAGE
#undef PG8_LDA
#undef PG8_LDB
#undef PG8_MMA
#undef PG8_WAIT_V
#undef PG8_WAIT_L
#undef PG8_BAR
#undef PG8_SCHED
}
}
using pg8::cvt_pk_bf16; using pg8::bf_lo; using pg8::bf_hi;

#define LDS_WAIT() asm volatile("s_waitcnt lgkmcnt(0)" ::: "memory")
__device__ __forceinline__ float wave_sum(float v) {
#pragma unroll
    for (int o = 1; o < 64; o <<= 1) v += __shfl_xor(v, o);
    return v;
}

__device__ __forceinline__ void tr_item(const float* W, int N, const float* g, bf16_t* WT, int ldT, int k_off, LAS float* scr, int item, int lane) {
    const int nblk = N / 32, kb = item / nblk, nb = item % nblk, k0 = 64 * kb, n0 = 32 * nb;
#pragma unroll 8
    for (int i = 0; i < 32; ++i) { const int kk = 2 * i + (lane >> 5); float v = W[(size_t)(k0 + kk) * N + n0 + (lane & 31)]; if (g) v *= g[k0 + kk]; scr[kk * 33 + (lane & 31)] = v; }
    LDS_WAIT(); asm volatile("" ::: "memory");
    const int c = lane & 7;
#pragma unroll
    for (int j = 0; j < 4; ++j) { const int n = (lane >> 3) + 8 * j; const LAS float* s = scr + (8 * c) * 33 + n;
        u32x4 o; o.x = cvt_pk_bf16(s[0 * 33], s[1 * 33]); o.y = cvt_pk_bf16(s[2 * 33], s[3 * 33]); o.z = cvt_pk_bf16(s[4 * 33], s[5 * 33]); o.w = cvt_pk_bf16(s[6 * 33], s[7 * 33]);
        *(u32x4*)(WT + (size_t)(n0 + n) * ldT + k_off + k0 + 8 * c) = o; }
    LDS_WAIT(); asm volatile("" ::: "memory");
}
__device__ __forceinline__ void pro_row(const float* xrow, bf16_t* xb, float* rout, int lane) {
    const f32x4* xr = (const f32x4*)xrow + lane; f32x4 v[4]; float s = 0.f;
#pragma unroll
    for (int j = 0; j < 4; ++j) { v[j] = xr[64 * j]; s += (v[j].x * v[j].x + v[j].y * v[j].y) + (v[j].z * v[j].z + v[j].w * v[j].w); }
    s = wave_sum(s);
    u32x2* o8 = (u32x2*)xb + lane;
#pragma unroll
    for (int j = 0; j < 4; ++j) { u32x2 w; w.x = cvt_pk_bf16(v[j].x, v[j].y); w.y = cvt_pk_bf16(v[j].z, v[j].w); o8[64 * j] = w; }
    if (lane == 0) *rout = 1.0f / sqrtf(s * (1.0f / 1024.0f) + RMS_EPS);
}
__device__ __forceinline__ void res_row(const float* xsrc, float* xdst, const bf16_t* t, const float* ssq16, const float* gpost, bf16_t* xb, float* rout, int lane) {
    const f32x4* sp = (const f32x4*)ssq16; const f32x4 s0 = sp[0], s1 = sp[1], s2 = sp[2], s3 = sp[3];
    const float tot = (((s0.x + s0.y) + (s0.z + s0.w)) + ((s1.x + s1.y) + (s1.z + s1.w))) + (((s2.x + s2.y) + (s2.z + s2.w)) + ((s3.x + s3.y) + (s3.z + s3.w)));
    const float rs = 1.0f / sqrtf(tot * (1.0f / 1024.0f) + RMS_EPS);
    const f32x4* xr = (const f32x4*)xsrc + lane; const f32x4* gr = (const f32x4*)gpost + lane; const u32x2* tr = (const u32x2*)t + lane;
    f32x4 v[4]; float s = 0.f;
#pragma unroll
    for (int j = 0; j < 4; ++j) { const f32x4 x = xr[64 * j], g = gr[64 * j]; const u32x2 tw = tr[64 * j];
        v[j].x = x.x + bf_lo(tw.x) * rs * g.x; v[j].y = x.y + bf_hi(tw.x) * rs * g.y; v[j].z = x.z + bf_lo(tw.y) * rs * g.z; v[j].w = x.w + bf_hi(tw.y) * rs * g.w;
        s += (v[j].x * v[j].x + v[j].y * v[j].y) + (v[j].z * v[j].z + v[j].w * v[j].w); }
    s = wave_sum(s);
    f32x4* xo = (f32x4*)xdst + lane; u32x2* o8 = (u32x2*)xb + lane;
#pragma unroll
    for (int j = 0; j < 4; ++j) { xo[64 * j] = v[j]; u32x2 w; w.x = cvt_pk_bf16(v[j].x, v[j].y); w.y = cvt_pk_bf16(v[j].z, v[j].w); o8[64 * j] = w; }
    if (lane == 0) *rout = 1.0f / sqrtf(s * (1.0f / 1024.0f) + RMS_EPS);
}

#define MFMA_F16(a, b, c) __builtin_amdgcn_mfma_f32_32x32x16_f16((a), (b), (c), 0, 0, 0)
__device__ __forceinline__ int crow(int reg, int h) { return (reg & 3) + 8 * (reg >> 2) + 4 * h; }
template <bool EARLY_EXIT>
__device__ __forceinline__ void attn_item(const f16_t* Q, const f16_t* Kb, const f16_t* VT, bf16_t* OU, int bh, int qblk, int lane) {
    const int r = lane & 31, hh = lane >> 5;
    const f16_t* qp = Q + ((size_t)bh * 4096 + qblk * 32 + r) * 64 + 8 * hh;
    h16x8 qf[4];
#pragma unroll
    for (int kk = 0; kk < 4; ++kk) qf[kk] = *(const h16x8*)(qp + 16 * kk);
    h16x8 ut[2];
#pragma unroll
    for (int st = 0; st < 2; ++st)
#pragma unroll
        for (int j = 0; j < 8; ++j) ut[st][j] = (crow(8 * st + j, hh) > r) ? (f16_t)1.0f : (f16_t)0.0f;
    f32x16 o0, o1;
#pragma unroll
    for (int i = 0; i < 16; ++i) { o0[i] = 0.f; o1[i] = 0.f; }
    float carry = 0.f;
    for (int kb = qblk; kb >= 0; --kb) {
        const bool diag = (kb == qblk);
        const f16_t* kp = Kb + ((size_t)bh * 4096 + kb * 32 + r) * 64 + 8 * hh;
        h16x8 kf[4];
#pragma unroll
        for (int kk = 0; kk < 4; ++kk) kf[kk] = *(const h16x8*)(kp + 16 * kk);
        const f16_t* vp = VT + ((size_t)bh * 128 + kb) * 2048 + r * 32 + 4 * hh;
        h16x8 vf[2][2];
#pragma unroll
        for (int dh = 0; dh < 2; ++dh)
#pragma unroll
            for (int st = 0; st < 2; ++st) { const h16x4 lo = *(const h16x4*)(vp + dh * 1024 + 16 * st), hi = *(const h16x4*)(vp + dh * 1024 + 16 * st + 8);
                vf[dh][st] = __builtin_shufflevector(lo, hi, 0, 1, 2, 3, 4, 5, 6, 7); }
        f32x16 s;
#pragma unroll
        for (int i = 0; i < 16; ++i) s[i] = 0.f;
#pragma unroll
        for (int kk = 0; kk < 4; ++kk) s = MFMA_F16(kf[kk], qf[kk], s);
        float lsum = 0.f; f32x16 lw; h16x8 Lp[2];
#pragma unroll
        for (int i = 0; i < 16; ++i) {
            const float z = fminf(s[i], 100.0f);
            const float sp = __builtin_amdgcn_logf(1.0f + __builtin_amdgcn_exp2f(z));
            const bool valid = !diag || (crow(i, hh) < r);
            const float L = valid ? -sp : 0.0f;
            lsum += L; lw[i] = z - sp; Lp[i >> 3][i & 7] = (f16_t)L;
        }
        f32x16 later;
#pragma unroll
        for (int i = 0; i < 16; ++i) later[i] = carry;
        later = MFMA_F16(ut[0], Lp[0], later); later = MFMA_F16(ut[1], Lp[1], later);
        h16x8 wp[2];
#pragma unroll
        for (int i = 0; i < 16; ++i) {
            const bool valid = !diag || (crow(i, hh) < r);
            const float w = valid ? __builtin_amdgcn_exp2f(lw[i] + later[i]) : 0.0f;
            wp[i >> 3][i & 7] = (f16_t)w;
        }
        o0 = MFMA_F16(vf[0][0], wp[0], o0); o0 = MFMA_F16(vf[0][1], wp[1], o0);
        o1 = MFMA_F16(vf[1][0], wp[0], o1); o1 = MFMA_F16(vf[1][1], wp[1], o1);
        lsum += __shfl_xor(lsum, 32); carry += lsum;
        if (EARLY_EXIT) { if (__all(carry < -160.0f)) break; }
    }
    const int b = bh >> 3, h = bh & 7;
    bf16_t* op = OU + (size_t)(b * 4096 + qblk * 32 + r) * 1024 + h * 64 + 4 * hh;
#pragma unroll
    for (int g4 = 0; g4 < 4; ++g4) {
        u32x2 w0; w0.x = cvt_pk_bf16(o0[4 * g4 + 0], o0[4 * g4 + 1]); w0.y = cvt_pk_bf16(o0[4 * g4 + 2], o0[4 * g4 + 3]);
        u32x2 w1; w1.x = cvt_pk_bf16(o1[4 * g4 + 0], o1[4 * g4 + 1]); w1.y = cvt_pk_bf16(o1[4 * g4 + 2], o1[4 * g4 + 3]);
        *(u32x2*)(op + 8 * g4) = w0; *(u32x2*)(op + 32 + 8 * g4) = w1;
    }
}
__device__ __forceinline__ void convmix_item(const bf16_t* CCC, const float* cw, bf16_t* OU, int item, int lane) {
    const int r0 = item * 32, c = lane * 8;
    float w0[8], w1[8], w2[8], p1[8], p2[8];
#pragma unroll
    for (int j = 0; j < 8; ++j) { w0[j] = cw[c + j]; w1[j] = cw[512 + c + j]; w2[j] = cw[1024 + c + j]; p1[j] = 0.f; p2[j] = 0.f; }
    const int rstart = ((r0 & 4095) == 0) ? r0 : r0 - 2;
    for (int row = rstart; row < r0 + 32; ++row) {
        const bf16_t* rp = CCC + (size_t)row * 1536 + c;
        const u32x4 cc = *(const u32x4*)(rp + 512), cx = *(const u32x4*)(rp + 1024);
        float p0[8];
#pragma unroll
        for (int q = 0; q < 4; ++q) { p0[2 * q] = bf_lo(cc[q]) * bf_lo(cx[q]); p0[2 * q + 1] = bf_hi(cc[q]) * bf_hi(cx[q]); }
        if (row >= r0) {
            const u32x4 cb = *(const u32x4*)rp; float o[8];
#pragma unroll
            for (int q = 0; q < 4; ++q) {
                o[2 * q] = bf_lo(cb[q]) * (w0[2 * q] * p2[2 * q] + w1[2 * q] * p1[2 * q] + w2[2 * q] * p0[2 * q]);
                o[2 * q + 1] = bf_hi(cb[q]) * (w0[2 * q + 1] * p2[2 * q + 1] + w1[2 * q + 1] * p1[2 * q + 1] + w2[2 * q + 1] * p0[2 * q + 1]);
            }
            u32x4 w; w.x = cvt_pk_bf16(o[0], o[1]); w.y = cvt_pk_bf16(o[2], o[3]); w.z = cvt_pk_bf16(o[4], o[5]); w.w = cvt_pk_bf16(o[6], o[7]);
            *(u32x4*)(OU + (size_t)row * 1024 + 512 + c) = w;
        }
#pragma unroll
        for (int j = 0; j < 8; ++j) { p2[j] = p1[j]; p1[j] = p0[j]; }
    }
}
__device__ __forceinline__ float gelu_tanh(float g) { const float t = 1.5957691216057308f * (g + 0.044715f * g * g * g); return g * __builtin_amdgcn_rcpf(1.0f + __builtin_amdgcn_exp2f(-1.4426950408889634f * t)); }
__device__ __forceinline__ void ffnact_item(const bf16_t* U, const float* cw, bf16_t* ACT, int item, int lane) {
    const int r0 = item * 8;
    for (int cgp = 0; cgp < 6; ++cgp) {
        const int c = cgp * 512 + lane * 8;
        if (c < D_FF) {
            float wa[3][8], wg[3][8], a1[8], a2[8], g1[8], g2[8];
#pragma unroll
            for (int i = 0; i < 3; ++i)
#pragma unroll
                for (int j = 0; j < 8; ++j) { wa[i][j] = cw[i * 2 * D_FF + c + j]; wg[i][j] = cw[i * 2 * D_FF + D_FF + c + j]; }
#pragma unroll
            for (int j = 0; j < 8; ++j) { a1[j] = a2[j] = g1[j] = g2[j] = 0.f; }
            const int rstart = ((r0 & 4095) == 0) ? r0 : r0 - 2;
            for (int row = rstart; row < r0 + 8; ++row) {
                const bf16_t* rp = U + (size_t)row * (2 * D_FF) + c;
                const u32x4 ua = *(const u32x4*)rp, ug = *(const u32x4*)(rp + D_FF);
                float a0[8], g0[8];
#pragma unroll
                for (int q = 0; q < 4; ++q) { a0[2 * q] = bf_lo(ua[q]); a0[2 * q + 1] = bf_hi(ua[q]); g0[2 * q] = bf_lo(ug[q]); g0[2 * q + 1] = bf_hi(ug[q]); }
                if (row >= r0) {
                    float o[8];
#pragma unroll
                    for (int j = 0; j < 8; ++j) {
                        const float av = wa[0][j] * a2[j] + wa[1][j] * a1[j] + wa[2][j] * a0[j];
                        const float gv = wg[0][j] * g2[j] + wg[1][j] * g1[j] + wg[2][j] * g0[j];
                        o[j] = gelu_tanh(gv) * av;
                    }
                    u32x4 w; w.x = cvt_pk_bf16(o[0], o[1]); w.y = cvt_pk_bf16(o[2], o[3]); w.z = cvt_pk_bf16(o[4], o[5]); w.w = cvt_pk_bf16(o[6], o[7]);
                    *(u32x4*)(ACT + (size_t)row * D_FF + c) = w;
                }
#pragma unroll
                for (int j = 0; j < 8; ++j) { a2[j] = a1[j]; a1[j] = a0[j]; g2[j] = g1[j]; g1[j] = g0[j]; }
            }
        }
    }
}


#define XB_TMO      128
#define XB_XCNT(j)  (256  + 64 * (j))
#define XB_XSUB(j)  (1280 + 64 * (j))
#define XB_XGEN(j)  (2304 + 64 * (j))
#define XB_TOP      3328
#define XB_TOPGEN   3392
#define XCD_BAR_WORDS 3456
#define XB_SPIN_CAP (1u << 22)
__device__ __forceinline__ unsigned xb_ld(unsigned* p)              { return __hip_atomic_load(p, __ATOMIC_RELAXED, __HIP_MEMORY_SCOPE_AGENT); }
__device__ __forceinline__ unsigned xb_add(unsigned* p, unsigned v) { return __hip_atomic_fetch_add(p, v, __ATOMIC_RELAXED, __HIP_MEMORY_SCOPE_AGENT); }
__device__ __forceinline__ unsigned xb_xcc_id() { return (unsigned)__builtin_amdgcn_s_getreg((3 << 11) | 20) & 0xFu; }
#define XB_SPIN(cond, bar) do { unsigned _sp = 0; while (cond) { __builtin_amdgcn_s_sleep(1); \
    if ((++_sp & 255u) == 0u) { if (xb_ld(&(bar)[XB_TMO])) break; if (_sp > XB_SPIN_CAP) { atomicAdd(&(bar)[XB_TMO], 1u); break; } } } } while (0)
struct XcdBarrier { unsigned* bar; unsigned x; volatile LAS unsigned* st; };
__device__ __forceinline__ void xcd_barrier_complete(unsigned* bar, unsigned x, unsigned& nloc, unsigned& nx) {
    const unsigned G = gridDim.x * gridDim.y * gridDim.z;
    unsigned sum, cnt, mine, sp = 0u;
    for (;;) {
        sum = 0u; cnt = 0u; mine = 0u;
#pragma unroll
        for (unsigned j = 0; j < 16; ++j) { const unsigned c = xb_ld(&bar[XB_XCNT(j)]); sum += c; cnt += (c > 0u) ? 1u : 0u; mine = (j == x) ? c : mine; }
        if (sum == G) break;
        __builtin_amdgcn_s_sleep(1);
        if ((++sp & 255u) == 0u) { if (xb_ld(&bar[XB_TMO])) break; if (sp > XB_SPIN_CAP) { atomicAdd(&bar[XB_TMO], 1u); break; } }
    }
    nloc = mine > 0u ? mine : 1u; nx = cnt > 0u ? cnt : 1u;
}
__device__ __forceinline__ void xcd_barrier(const XcdBarrier& b) {
    asm volatile("s_waitcnt vmcnt(0)" ::: "memory");
    __syncthreads();
    if (threadIdx.x == 0) {
        unsigned* bar = b.bar;
        __builtin_amdgcn_s_waitcnt(0);
        unsigned nloc = b.st[0], nx = b.st[1];
        if (nloc == 0u) { xcd_barrier_complete(bar, b.x, nloc, nx); b.st[0] = nloc; b.st[1] = nx; }
        const unsigned old = xb_add(&bar[XB_XSUB(b.x)], 1u);
        const unsigned gen = old / nloc;
        if (old + 1u == (gen + 1u) * nloc) {
            __builtin_amdgcn_fence(__ATOMIC_RELEASE, "agent");
            asm volatile("s_waitcnt vmcnt(0)" ::: "memory");
            const unsigned og = xb_add(&bar[XB_TOP], 1u);
            const unsigned tg = og / nx;
            if (og + 1u == (tg + 1u) * nx) xb_add(&bar[XB_TOPGEN], 1u);
            else XB_SPIN(xb_ld(&bar[XB_TOPGEN]) == tg, bar);
            __builtin_amdgcn_fence(__ATOMIC_ACQUIRE, "agent");
            xb_add(&bar[XB_XGEN(b.x)], 1u);
            asm volatile("s_waitcnt vmcnt(0)" ::: "memory");
        } else {
            XB_SPIN(xb_ld(&bar[XB_XGEN(b.x)]) == gen, bar);
            __builtin_amdgcn_fence(__ATOMIC_ACQUIRE, "agent");
            asm volatile("s_waitcnt vmcnt(0)" ::: "memory");
        }
    }
    __syncthreads();
}


#ifndef STOP_AFTER
#define STOP_AFTER -1
#endif
__device__ __forceinline__ void dbg_dump(float* out, const bf16_t* buf, size_t count) {
    const size_t tot = (size_t)gridDim.x * 512, i0 = (size_t)blockIdx.x * 512 + threadIdx.x;
    for (size_t i = i0; i < (size_t)MTOT * D_MODEL; i += tot) out[i] = i < count ? __uint_as_float((unsigned)buf[i] << 16) : 0.0f;
}
#define DBG_STOP(k, off, count) do { if (STOP_AFTER == (k) && hl == 0) { dbg_dump(a.out, (const bf16_t*)(a.ws + (off)), (count)); return; } } while (0)
struct Args { const float* in[13]; float* out; unsigned char* ws; };
#ifndef ATT_EARLY_EXIT
#define ATT_EARLY_EXIT true
#endif

#define LAUNDER_S(p) asm volatile("" : "+s"(p))
#define LAUNDER_V(v) asm volatile("" : "+v"(v))
#define PHASE_BEGIN() unsigned char* ws = a.ws; LAUNDER_S(ws); int lane; asm volatile("v_mbcnt_lo_u32_b32 %0, -1, 0\n\tv_mbcnt_hi_u32_b32 %0, -1, %0" : "=v"(lane)); \
    int wave = wave0; LAUNDER_S(wave); const int G = gridDim.x, gw = blockIdx.x * 8 + wave, NGW = G * 8; (void)gw; (void)NGW; (void)lane; \
    unsigned char* wl = ws + WS_W + (size_t)l * W_LAYER; (void)wl

__global__ void __launch_bounds__(512, 2) hybrid_fwd(Args a) {
    extern __shared__ __attribute__((aligned(16))) unsigned char lds_raw[];
    LAS unsigned char* lds = (LAS unsigned char*)lds_raw;
    cg::grid_group grid = cg::this_grid();
    const int wave0 = __builtin_amdgcn_readfirstlane(threadIdx.x >> 6);
    if (threadIdx.x < 4) ((volatile LAS unsigned*)(lds + 131072))[threadIdx.x] = 0u;
    __syncthreads();
    if (threadIdx.x == 0) (void)xb_add((unsigned*)a.ws + XB_XCNT(xb_xcc_id()), 1u);
#define GRID_SYNC() do { XcdBarrier _b; _b.bar = (unsigned*)a.ws; _b.x = xb_xcc_id(); _b.st = (volatile LAS unsigned*)(lds + 131072); xcd_barrier(_b); } while (0)

    for (int hl = 0; hl < NHALF * DEPTH; ++hl) {
        const int half = hl / DEPTH, l = hl % DEPTH;
        const size_t xoff = (size_t)half * MH * D_MODEL;
        if (l == 0) {
            PHASE_BEGIN();
            if (half == 0) {
                LAS float* scr = (LAS float*)(lds + wave * 16384);
                constexpr int I_IN = 16 * (IN_COLS / 32), I_BR = 8 * 32, I_OUT = 16 * 32, I_UP = 16 * (2 * D_FF / 32), I_DN = (D_FF / 64) * 32, I_L = I_IN + 2 * I_BR + I_OUT + I_UP + I_DN;
                for (int it = gw; it < DEPTH * I_L; it += NGW) {
                    const int ll = it / I_L; int r = it % I_L;
                    unsigned char* wll = ws + WS_W + (size_t)ll * W_LAYER;
                    if (r < I_IN) { tr_item(a.in[2] + (size_t)ll * 1024 * IN_COLS, IN_COLS, a.in[1] + ll * 1024, (bf16_t*)(wll + W_IN), 1024, 0, scr, r, lane); continue; } r -= I_IN;
                    if (r < I_BR) { tr_item(a.in[4] + (size_t)ll * 512 * 1024, 1024, nullptr, (bf16_t*)(wll + W_BR), 1024, 0, scr, r, lane); continue; } r -= I_BR;
                    if (r < I_BR) { tr_item(a.in[5] + (size_t)ll * 512 * 1024, 1024, nullptr, (bf16_t*)(wll + W_BR), 1024, 512, scr, r, lane); continue; } r -= I_BR;
                    if (r < I_OUT) { tr_item(a.in[6] + (size_t)ll * 1024 * 1024, 1024, nullptr, (bf16_t*)(wll + W_OUT), 1024, 0, scr, r, lane); continue; } r -= I_OUT;
                    if (r < I_UP) { tr_item(a.in[9] + (size_t)ll * 1024 * 2 * D_FF, 2 * D_FF, a.in[8] + ll * 1024, (bf16_t*)(wll + W_UP), 1024, 0, scr, r, lane); continue; } r -= I_UP;
                    tr_item(a.in[11] + (size_t)ll * D_FF * 1024, 1024, nullptr, (bf16_t*)(wll + W_DN), D_FF, 0, scr, r, lane);
                }
            }
            for (int m = gw; m < MH; m += NGW) pro_row(a.in[0] + xoff + (size_t)m * 1024, (bf16_t*)(ws + WS_XB) + (size_t)m * 1024, (float*)(ws + WS_R) + m, lane);
            GRID_SYNC();
        }
        { PHASE_BEGIN();
          pg8::Gemm g{(const bf16_t*)(ws + WS_XB), (const bf16_t*)(wl + W_IN), MH, IN_COLS, 1024}; pg8::StaticOrder S; S.init(MH, IN_COLS, G, (int)blockIdx.x);
          pg8::EpiIn E{(const float*)(ws + WS_R), (f16_t*)(ws + WS_Q), (f16_t*)(ws + WS_K), (f16_t*)(ws + WS_VT), (bf16_t*)(ws + WS_CCC), (bf16_t*)(ws + WS_G)};
          pg8::gemm_phase<pg8::EpiIn>(lds, g, S, E, wave, lane); }
        GRID_SYNC();
        DBG_STOP(1, WS_G, (size_t)MH * 2048);
        { PHASE_BEGIN();
          const f16_t* Qb = (const f16_t*)(ws + WS_Q); const f16_t* Kb = (const f16_t*)(ws + WS_K); const f16_t* VT = (const f16_t*)(ws + WS_VT); bf16_t* OU = (bf16_t*)(ws + WS_OU);
          for (int it = gw; it < 32 * 64; it += NGW) {
              const int bh = it >> 6, i = it & 63;
              attn_item<ATT_EARLY_EXIT>(Qb, Kb, VT, OU, bh, 127 - i, lane);
              attn_item<ATT_EARLY_EXIT>(Qb, Kb, VT, OU, bh, i, lane);
          }
          for (int it = gw; it < MH / 32; it += NGW) convmix_item((const bf16_t*)(ws + WS_CCC), a.in[3] + (size_t)l * 3 * CONVW, OU, it, lane); }
        GRID_SYNC();
        DBG_STOP(2, WS_OU, (size_t)MH * 1024);
        { PHASE_BEGIN();
          pg8::Gemm g{(const bf16_t*)(ws + WS_OU), (const bf16_t*)(wl + W_BR), MH, 1024, 1024}; pg8::StaticOrder S; S.init(MH, 1024, G, (int)blockIdx.x);
          pg8::EpiMerge E{(const bf16_t*)(ws + WS_G), (bf16_t*)(ws + WS_MG)}; pg8::gemm_phase<pg8::EpiMerge>(lds, g, S, E, wave, lane); }
        GRID_SYNC();
        DBG_STOP(3, WS_MG, (size_t)MH * 1024);
        { PHASE_BEGIN();
          pg8::Gemm g{(const bf16_t*)(ws + WS_MG), (const bf16_t*)(wl + W_OUT), MH, 1024, 1024}; pg8::StaticOrder S; S.init(MH, 1024, G, (int)blockIdx.x);
          pg8::EpiNormOut E{(bf16_t*)(ws + WS_T), (float*)(ws + WS_SSQ)}; pg8::gemm_phase<pg8::EpiNormOut>(lds, g, S, E, wave, lane); }
        GRID_SYNC();
        DBG_STOP(4, WS_T, (size_t)MH * 1024);
        { PHASE_BEGIN();
          const float* xs = (l == 0 ? a.in[0] : a.out) + xoff;
          for (int m = gw; m < MH; m += NGW) res_row(xs + (size_t)m * 1024, a.out + xoff + (size_t)m * 1024, (const bf16_t*)(ws + WS_T) + (size_t)m * 1024, (const float*)(ws + WS_SSQ) + (size_t)m * 16,
                                                     a.in[7] + l * 1024, (bf16_t*)(ws + WS_XB) + (size_t)m * 1024, (float*)(ws + WS_R) + m, lane); }
        GRID_SYNC();
        DBG_STOP(5, WS_XB, (size_t)MH * 1024);
        { PHASE_BEGIN();
          pg8::Gemm g{(const bf16_t*)(ws + WS_XB), (const bf16_t*)(wl + W_UP), MH, 2 * D_FF, 1024}; pg8::StaticOrder S; S.init(MH, 2 * D_FF, G, (int)blockIdx.x);
          pg8::EpiScale E{(const float*)(ws + WS_R), (bf16_t*)(ws + WS_U), 2 * D_FF}; pg8::gemm_phase<pg8::EpiScale>(lds, g, S, E, wave, lane); }
        GRID_SYNC();
        DBG_STOP(6, WS_U, (size_t)MH * 2048);
        { PHASE_BEGIN();
          for (int it = gw; it < MH / 8; it += NGW) ffnact_item((const bf16_t*)(ws + WS_U), a.in[10] + (size_t)l * 3 * 2 * D_FF, (bf16_t*)(ws + WS_ACT), it, lane); }
        GRID_SYNC();
        DBG_STOP(7, WS_ACT, (size_t)MH * 2048);
        { PHASE_BEGIN();
          pg8::Gemm g{(const bf16_t*)(ws + WS_ACT), (const bf16_t*)(wl + W_DN), MH, 1024, D_FF}; pg8::StaticOrder S; S.init(MH, 1024, G, (int)blockIdx.x);
          pg8::EpiNormOut E{(bf16_t*)(ws + WS_F), (float*)(ws + WS_SSQ)}; pg8::gemm_phase<pg8::EpiNormOut>(lds, g, S, E, wave, lane); }
        GRID_SYNC();
        DBG_STOP(8, WS_F, (size_t)MH * 1024);
        { PHASE_BEGIN();
          for (int m = gw; m < MH; m += NGW) res_row(a.out + xoff + (size_t)m * 1024, a.out + xoff + (size_t)m * 1024, (const bf16_t*)(ws + WS_F) + (size_t)m * 1024, (const float*)(ws + WS_SSQ) + (size_t)m * 16,
                                                     a.in[12] + l * 1024, (bf16_t*)(ws + WS_XB) + (size_t)m * 1024, (float*)(ws + WS_R) + m, lane); }
        GRID_SYNC();
    }
    grid.sync();
}

extern "C" void kernel_launch(void* const* d_in, const int* in_sizes, int n_in, void* d_out, int out_size, void* d_ws, size_t ws_size, hipStream_t stream) {
    static int grid = 0;
    if (grid == 0) {
        if (n_in != 13 || in_sizes[0] != MTOT * D_MODEL || out_size != MTOT * D_MODEL || ws_size < WS_END) {
            fprintf(stderr, "kernel_launch: unexpected shapes (n_in %d, in0 %d, out %d, ws %zu)\n", n_in, n_in > 0 ? in_sizes[0] : -1, out_size, ws_size); grid = -1; return; }
        int dev = 0, cus = 0, per_cu = 0;
        (void)hipGetDevice(&dev);
        (void)hipDeviceGetAttribute(&cus, hipDeviceAttributeMultiprocessorCount, dev);
        (void)hipFuncSetAttribute((const void*)hybrid_fwd, hipFuncAttributeMaxDynamicSharedMemorySize, LDS_BYTES);
        if (hipOccupancyMaxActiveBlocksPerMultiprocessor(&per_cu, (const void*)hybrid_fwd, 512, LDS_BYTES) != hipSuccess || per_cu < 1) per_cu = 1;
        (void)hipGetLastError();
        grid = cus * per_cu;
    }
    if (grid < 0) return;
    if (hipMemsetAsync(d_ws, 0, 16384, stream) != hipSuccess) { fprintf(stderr, "kernel_launch: memset of the barrier words failed\n"); return; }
    Args a{};
    for (int i = 0; i < 13; ++i) a.in[i] = (const float*)d_in[i];
    a.out = (float*)d_out; a.ws = (unsigned char*)d_ws;
    void* args[] = {&a};
    hipError_t e = hipLaunchCooperativeKernel((const void*)hybrid_fwd, dim3(grid), dim3(512), args, LDS_BYTES, stream);
    if (e != hipSuccess) fprintf(stderr, "cooperative launch failed: %s (grid %d)\n", hipGetErrorString(e), grid);
}
```
